# Optimizing an MI355X kernel written in HIP

```python
import math
import jax
import jax.numpy as jnp
from jax import lax
import numpy as np

D_MODEL = 1024
BATCH = 1
SEQ = 16384
DEPTH = 4
DEC_BATCH = 8
DEC_SEQ = 8192
PAST_LEN = 128

N_EVEN = (DEPTH + 1) // 2
N_ODD = DEPTH // 2
N_MEM = 256
EPS = 1e-6
GN_EPS = 1e-5
CHUNK = 128

MLSTM_HEADS = 4
MLSTM_WIDTH = D_MODEL
MLSTM_HD = MLSTM_WIDTH // MLSTM_HEADS
N_GATE_COLS = 4 * MLSTM_HEADS

HYENA_WIDTH = D_MODEL
HYENA_EMB = 33
HYENA_BANDS = (HYENA_EMB - 1) // 2
HYENA_HIDDEN = 64
HYENA_SHIFT = 0.05
HYENA_FAST_PCT = 0.3
HYENA_SLOW_PCT = 1.5
HYENA_TARGET = 1e-2

RET_HEADS = 4
RET_QK = D_MODEL
RET_V = 2 * D_MODEL
RET_HDK = RET_QK // RET_HEADS
RET_HDV = RET_V // RET_HEADS
ROPE_BASE = 10000.0

CA_HEADS = 4
CA_HD = D_MODEL // CA_HEADS

SHORT_CONV = 3
EVEN_COLS = 5 * MLSTM_WIDTH + N_GATE_COLS + 4 * HYENA_WIDTH
ODD_COLS = 2 * RET_QK + 2 * RET_V

kernel_name = 'hybrid_mlstm_hyena_retention_encoder'


def _rmsnorm(x, g):
    xf = x.astype(jnp.float32)
    y = xf * lax.rsqrt(jnp.mean(xf * xf, axis=-1, keepdims=True) + EPS)
    return (y * g.astype(jnp.float32)).astype(x.dtype)


def _heads(x, n):
    b, l, c = x.shape
    return x.reshape(b, l, n, c // n).transpose(0, 2, 1, 3)


def _merge(x):
    b, h, l, d = x.shape
    return x.transpose(0, 2, 1, 3).reshape(b, l, h * d)


def _flip(a):
    return jnp.flip(a, axis=2)


def _head_layernorm(o, g):
    mu = jnp.mean(o, axis=-1, keepdims=True)
    var = jnp.mean(jnp.square(o - mu), axis=-1, keepdims=True)
    return _merge((o - mu) * lax.rsqrt(var + GN_EPS)) * g.astype(jnp.float32)


def _short_conv(x, w, b):
    w = w.astype(jnp.float32)
    xp = jnp.pad(x, ((0, 0), (1, 1), (0, 0)))
    return xp[:, :-2] * w[0] + xp[:, 1:-1] * w[1] + xp[:, 2:] * w[2] + b.astype(jnp.float32)


def _rope(x):
    l, d = x.shape[2], x.shape[3]
    inv = ROPE_BASE ** (-jnp.arange(0, d, 2, dtype=jnp.float32) / d)
    ang = jnp.arange(l, dtype=jnp.float32)[:, None] * inv[None, :]
    c, s = jnp.cos(ang), jnp.sin(ang)
    x1, x2 = jnp.split(x, 2, axis=-1)
    return jnp.concatenate([x1 * c - x2 * s, x1 * s + x2 * c], axis=-1)


def _to_chunks(a):
    b, h, l = a.shape[:3]
    a = a.reshape(b, h, l // CHUNK, CHUNK, *a.shape[3:])
    return jnp.moveaxis(a, 2, 0)


def _from_chunks(a):
    nc, b, h, t = a.shape[:4]
    return jnp.moveaxis(a, 0, 2).reshape(b, h, nc * t, *a.shape[4:])


def _mlstm_scan(q, k, v, ig, lf):
    b, h, l, dh = q.shape
    causal = jnp.tril(jnp.ones((CHUNK, CHUNK), dtype=bool))

    def step(carry, inp):
        c_st, n_st, m_st = carry
        qq, kk, vv, ii, ff = inp
        bcum = jnp.cumsum(ff, axis=-1)
        dmat = bcum[..., :, None] - bcum[..., None, :] + ii[..., None, :]
        dmat = jnp.where(causal, dmat, -jnp.inf)
        inter = bcum + m_st[..., None]
        m_t = jnp.maximum(jnp.max(dmat, axis=-1), inter)
        s = jnp.einsum('bhtd,bhsd->bhts', qq, kk) * jnp.exp(dmat - m_t[..., None])
        sc = jnp.exp(inter - m_t)
        num = jnp.einsum('bhts,bhsv->bhtv', s, vv) + sc[..., None] * jnp.einsum('bhvk,bhtk->bhtv', c_st, qq)
        den = jnp.sum(s, axis=-1) + sc * jnp.einsum('bhk,bhtk->bht', n_st, qq)
        out = num / jnp.maximum(jnp.abs(den), jnp.exp(-m_t))[..., None]
        btot = bcum[..., -1]
        gk = btot[..., None] - bcum + ii
        m_new = jnp.maximum(btot + m_st, jnp.max(gk, axis=-1))
        dec = jnp.exp(btot + m_st - m_new)
        wk = jnp.exp(gk - m_new[..., None])
        c_new = dec[..., None, None] * c_st + jnp.einsum('bhs,bhsv,bhsk->bhvk', wk, vv, kk)
        n_new = dec[..., None] * n_st + jnp.einsum('bhs,bhsk->bhk', wk, kk)
        return (c_new, n_new, m_new), out

    init = (jnp.zeros((b, h, dh, dh), jnp.float32), jnp.zeros((b, h, dh), jnp.float32),
            jnp.zeros((b, h), jnp.float32))
    _, hs = lax.scan(step, init, (_to_chunks(q), _to_chunks(k), _to_chunks(v), _to_chunks(ig), _to_chunks(lf)))
    return _from_chunks(hs)


def _retention_scan(q, k, v, log_gamma):
    b, h, l, dk = q.shape
    dv = v.shape[-1]
    pos = jnp.arange(CHUNK, dtype=jnp.float32)
    rel = pos[:, None] - pos[None, :]
    lg = log_gamma[:, None, None]
    dmask = jnp.where(rel >= 0, jnp.exp(lg * jnp.maximum(rel, 0.0)), 0.0)
    q_dec = jnp.exp(lg * (pos[:, None] + 1.0))
    k_dec = jnp.exp(lg * (CHUNK - 1.0 - pos[:, None]))
    c_dec = jnp.exp(lg * CHUNK)

    def step(r_st, inp):
        qq, kk, vv = inp
        s = jnp.einsum('bhtd,bhsd->bhts', qq, kk) * dmask
        out = jnp.einsum('bhts,bhsv->bhtv', s, vv) + jnp.einsum('bhtd,bhdv->bhtv', qq * q_dec, r_st)
        r_new = c_dec * r_st + jnp.einsum('bhsd,bhsv->bhdv', kk * k_dec, vv)
        return r_new, out

    init = jnp.zeros((b, h, dk, dv), jnp.float32)
    _, os_ = lax.scan(step, init, (_to_chunks(q), _to_chunks(k), _to_chunks(v)))
    return _from_chunks(os_)


def _hyena_filter(l, w1, b1, f1, w2, b2, f2, w3, delta):
    f32 = jnp.float32
    t = jnp.linspace(0.0, 1.0, l, dtype=f32)[:, None]
    j = jnp.arange(l, dtype=f32)[:, None]
    bands = jnp.linspace(1e-4, HYENA_BANDS - 1, HYENA_BANDS, dtype=f32)[None, :]
    ang = (2.0 * math.pi / l) * bands * j
    feats = jnp.concatenate([t, jnp.cos(ang), -jnp.sin(ang)], axis=-1)
    z = jnp.sin(f1.astype(f32) * (feats @ w1.astype(f32) + b1.astype(f32)))
    z = jnp.sin(f2.astype(f32) * (z @ w2.astype(f32) + b2.astype(f32)))
    hk = z @ w3.astype(f32)
    hk = hk * (jnp.exp(-t * jnp.abs(delta.astype(f32))) + HYENA_SHIFT)
    h_fwd, h_bwd = jnp.split(hk, 2, axis=-1)
    kern = jnp.concatenate([h_fwd, jnp.zeros_like(h_fwd[:1]), jnp.flip(h_bwd[1:], axis=0)], axis=0)
    return kern / jnp.sum(jnp.abs(kern), axis=0, keepdims=True)


def _fft_conv(u, kern):
    l = u.shape[1]
    uf = jnp.fft.rfft(u, n=2 * l, axis=1)
    kf = jnp.fft.rfft(kern, n=2 * l, axis=0)
    return jnp.fft.irfft(uf * kf[None], n=2 * l, axis=1)[:, :l]


def _even_mixer(h, p, i):
    f32 = jnp.float32
    b, l, _ = h.shape
    w, nh = MLSTM_WIDTH, MLSTM_HEADS
    proj = jnp.matmul(h, p['even_w_in'][i]).astype(f32)
    qk, v_a, o_a, z_a, gates, hy, z_b = jnp.split(
        proj, [2 * w, 3 * w, 4 * w, 5 * w, 5 * w + N_GATE_COLS, 5 * w + N_GATE_COLS + 3 * HYENA_WIDTH], axis=-1)
    qk = jax.nn.silu(_short_conv(qk, p['mlstm_conv_w'][i], p['mlstm_conv_b'][i]))
    q, k = jnp.split(qk, 2, axis=-1)
    q = _heads(q, nh)
    k = _heads(k, nh) * MLSTM_HD ** -0.5
    v = _heads(v_a, nh)
    g = gates.reshape(b, l, 2, 2, nh) + p['mlstm_gate_bias'][i].astype(f32)
    g = jnp.moveaxis(g, 1, -1)
    ig_f, lf_f = g[:, 0, 0], jax.nn.log_sigmoid(g[:, 0, 1])
    ig_b, lf_b = g[:, 1, 0], jax.nn.log_sigmoid(g[:, 1, 1])
    h_f = _mlstm_scan(q, k, v, ig_f, lf_f)
    h_b = _flip(_mlstm_scan(_flip(q), _flip(k), _flip(v), _flip(ig_b), _flip(lf_b)))
    y_a = _head_layernorm(h_f + h_b, p['mlstm_norm_g'][i]) * jax.nn.sigmoid(o_a) * jax.nn.silu(z_a)
    hy = _short_conv(hy, p['hyena_conv_w'][i], p['hyena_conv_b'][i])
    x0, x1, vh = jnp.split(hy, 3, axis=-1)
    kern = _hyena_filter(l, p['hyena_w1'][i], p['hyena_b1'][i], p['hyena_freq1'][i], p['hyena_w2'][i],
                         p['hyena_b2'][i], p['hyena_freq2'][i], p['hyena_w3'][i], p['hyena_delta'][i])
    t = x1 * vh
    y_b = x0 * (_fft_conv(t, kern) + p['hyena_skip'][i].astype(f32) * t)
    y_b = y_b * jax.nn.silu(z_b)
    return jnp.concatenate([y_a, y_b], axis=-1) @ p['even_w_out'][i].astype(f32)


def _odd_mixer(h, p, i):
    f32 = jnp.float32
    proj = jnp.matmul(h, p['odd_w_in'][i]).astype(f32)
    q, k, v, g = jnp.split(proj, [RET_QK, 2 * RET_QK, 2 * RET_QK + RET_V], axis=-1)
    q = _rope(_heads(q, RET_HEADS)) * RET_HDK ** -0.5
    k = _rope(_heads(k, RET_HEADS))
    v = _heads(v, RET_HEADS)
    lg = jax.nn.log_sigmoid(p['ret_decay_logit'][i].astype(f32))
    o_f = _retention_scan(q, k, v, lg[0])
    o_b = _flip(_retention_scan(_flip(q), _flip(k), _flip(v), lg[1]))
    o = _head_layernorm(o_f + o_b, p['ret_norm_g'][i])
    return (jax.nn.silu(g) * o) @ p['odd_w_out'][i].astype(f32)


def _cross_attn(h, m, wq, wkv, wo):
    f32 = jnp.float32
    q = _heads(jnp.matmul(h, wq), CA_HEADS).astype(f32)
    k, v = jnp.split(jnp.matmul(m, wkv), 2, axis=-1)
    k = _heads(k, CA_HEADS).astype(f32)
    v = _heads(v, CA_HEADS).astype(f32)
    s = jnp.einsum('bhtd,bhmd->bhtm', q, k) * CA_HD ** -0.5
    a = jax.nn.softmax(s, axis=-1)
    o = jnp.einsum('bhtm,bhmd->bhtd', a, v)
    return _merge(o) @ wo.astype(f32)


def _trunk(x, mem, p):
    for layer in range(DEPTH):
        i = layer // 2
        hn = _rmsnorm(x, p['norm_mix_g'][layer])
        mix = _even_mixer(hn, p, i) if layer % 2 == 0 else _odd_mixer(hn, p, i)
        x = x + mix.astype(x.dtype)
        hq = _rmsnorm(x, p['norm_ca_g'][layer])
        mn = _rmsnorm(mem, p['norm_mem_g'][layer])
        x = x + _cross_attn(hq, mn, p['ca_wq'][layer], p['ca_wkv'][layer], p['ca_wo'][layer]).astype(x.dtype)
    return _rmsnorm(x, p['norm_final_g'])


def setup_inputs(seed: int = 0) -> dict:
    key = jax.random.key(seed)
    it = iter(jax.random.split(key, 48))
    f32 = jnp.float32

    def nrm(shape, scale):
        return jax.random.normal(next(it), shape, f32) * scale

    def gain(shape):
        return 1.0 + nrm(shape, 0.01)

    d, w, nh = D_MODEL, MLSTM_WIDTH, MLSTM_HEADS
    x_prompt = nrm((BATCH, SEQ, d), 1.0)
    x_sample = nrm((DEC_BATCH, DEC_SEQ, d), 1.0)
    mem_prompt = nrm((BATCH, N_MEM, d), 1.0)
    mem_sample = nrm((DEC_BATCH, N_MEM, d), 1.0)
    norm_mix_g = gain((DEPTH, d))
    norm_ca_g = gain((DEPTH, d))
    norm_mem_g = gain((DEPTH, d))
    norm_final_g = gain((d,))
    even_w_in = nrm((N_EVEN, d, EVEN_COLS), d ** -0.5)
    mlstm_conv_w = nrm((N_EVEN, SHORT_CONV, 2 * w), SHORT_CONV ** -0.5)
    mlstm_conv_b = nrm((N_EVEN, 2 * w), 0.01)
    ib = nrm((N_EVEN, 2, 1, nh), 0.1)
    fb = jnp.broadcast_to(jnp.linspace(3.0, 6.0, nh, dtype=f32), (N_EVEN, 2, 1, nh)) + nrm((N_EVEN, 2, 1, nh), 0.01)
    mlstm_gate_bias = jnp.concatenate([ib, fb], axis=2)
    mlstm_norm_g = gain((N_EVEN, w))
    hyena_conv_w = nrm((N_EVEN, SHORT_CONV, 3 * HYENA_WIDTH), SHORT_CONV ** -0.5)
    hyena_conv_b = nrm((N_EVEN, 3 * HYENA_WIDTH), 0.01)
    hyena_w1 = nrm((N_EVEN, HYENA_EMB, HYENA_HIDDEN), HYENA_EMB ** -0.5)
    hyena_b1 = nrm((N_EVEN, HYENA_HIDDEN), 0.01)
    hyena_freq1 = gain((N_EVEN, HYENA_HIDDEN))
    hyena_w2 = nrm((N_EVEN, HYENA_HIDDEN, HYENA_HIDDEN), HYENA_HIDDEN ** -0.5)
    hyena_b2 = nrm((N_EVEN, HYENA_HIDDEN), 0.01)
    hyena_freq2 = gain((N_EVEN, HYENA_HIDDEN))
    hyena_w3 = nrm((N_EVEN, HYENA_HIDDEN, 2 * HYENA_WIDTH), HYENA_HIDDEN ** -0.5)
    min_decay = math.log(HYENA_TARGET) / HYENA_SLOW_PCT
    max_decay = math.log(HYENA_TARGET) / HYENA_FAST_PCT
    base = jnp.tile(jnp.linspace(min_decay, max_decay, HYENA_WIDTH, dtype=f32), 2)
    hyena_delta = base[None, :] + nrm((N_EVEN, 2 * HYENA_WIDTH), 0.01)
    hyena_skip = nrm((N_EVEN, HYENA_WIDTH), 1.0)
    even_w_out = nrm((N_EVEN, w + HYENA_WIDTH, d), (w + HYENA_WIDTH) ** -0.5)
    odd_w_in = nrm((N_ODD, d, ODD_COLS), d ** -0.5)
    logit = np.log(2.0 ** (5.0 + np.arange(RET_HEADS)) - 1.0).astype(np.float32)
    ret_decay_logit = jnp.broadcast_to(jnp.asarray(logit), (N_ODD, 2, RET_HEADS)) + nrm((N_ODD, 2, RET_HEADS), 0.01)
    ret_norm_g = gain((N_ODD, RET_V))
    odd_w_out = nrm((N_ODD, RET_V, d), RET_V ** -0.5)
    ca_wq = nrm((DEPTH, d, d), d ** -0.5)
    ca_wkv = nrm((DEPTH, d, 2 * d), d ** -0.5)
    ca_wo = nrm((DEPTH, d, d), d ** -0.5)
    return {'x_prompt': x_prompt, 'x_sample': x_sample, 'mem_prompt': mem_prompt, 'mem_sample': mem_sample,
            'norm_mix_g': norm_mix_g, 'norm_ca_g': norm_ca_g, 'norm_mem_g': norm_mem_g, 'norm_final_g': norm_final_g,
            'even_w_in': even_w_in, 'mlstm_conv_w': mlstm_conv_w, 'mlstm_conv_b': mlstm_conv_b,
            'mlstm_gate_bias': mlstm_gate_bias, 'mlstm_norm_g': mlstm_norm_g,
            'hyena_conv_w': hyena_conv_w, 'hyena_conv_b': hyena_conv_b, 'hyena_w1': hyena_w1, 'hyena_b1': hyena_b1,
            'hyena_freq1': hyena_freq1, 'hyena_w2': hyena_w2, 'hyena_b2': hyena_b2, 'hyena_freq2': hyena_freq2,
            'hyena_w3': hyena_w3, 'hyena_delta': hyena_delta, 'hyena_skip': hyena_skip, 'even_w_out': even_w_out,
            'odd_w_in': odd_w_in, 'ret_decay_logit': ret_decay_logit, 'ret_norm_g': ret_norm_g, 'odd_w_out': odd_w_out,
            'ca_wq': ca_wq, 'ca_wkv': ca_wkv, 'ca_wo': ca_wo}


def reference(x_prompt, x_sample, mem_prompt, mem_sample, norm_mix_g, norm_ca_g, norm_mem_g, norm_final_g,
              even_w_in, mlstm_conv_w, mlstm_conv_b, mlstm_gate_bias, mlstm_norm_g,
              hyena_conv_w, hyena_conv_b, hyena_w1, hyena_b1, hyena_freq1, hyena_w2, hyena_b2, hyena_freq2,
              hyena_w3, hyena_delta, hyena_skip, even_w_out,
              odd_w_in, ret_decay_logit, ret_norm_g, odd_w_out, ca_wq, ca_wkv, ca_wo):
    p = {'norm_mix_g': norm_mix_g, 'norm_ca_g': norm_ca_g, 'norm_mem_g': norm_mem_g, 'norm_final_g': norm_final_g,
         'even_w_in': even_w_in, 'mlstm_conv_w': mlstm_conv_w, 'mlstm_conv_b': mlstm_conv_b,
         'mlstm_gate_bias': mlstm_gate_bias, 'mlstm_norm_g': mlstm_norm_g,
         'hyena_conv_w': hyena_conv_w, 'hyena_conv_b': hyena_conv_b, 'hyena_w1': hyena_w1, 'hyena_b1': hyena_b1,
         'hyena_freq1': hyena_freq1, 'hyena_w2': hyena_w2, 'hyena_b2': hyena_b2, 'hyena_freq2': hyena_freq2,
         'hyena_w3': hyena_w3, 'hyena_delta': hyena_delta, 'hyena_skip': hyena_skip, 'even_w_out': even_w_out,
         'odd_w_in': odd_w_in, 'ret_decay_logit': ret_decay_logit, 'ret_norm_g': ret_norm_g, 'odd_w_out': odd_w_out,
         'ca_wq': ca_wq, 'ca_wkv': ca_wkv, 'ca_wo': ca_wo}
    y_prompt = _trunk(x_prompt, mem_prompt, p)
    y_sample = _trunk(x_sample, mem_sample, p)
    return (y_prompt, y_sample)
```

```cpp
#include <hip/hip_runtime.h>
#include <hip/hip_cooperative_groups.h>
#include <stdint.h>
#include <stdio.h>
namespace cg = cooperative_groups;
#define GSYNC() xcd_barrier(xb)

typedef unsigned short u16;
typedef __attribute__((ext_vector_type(8))) short bf16x8;
typedef __attribute__((ext_vector_type(16))) float f32x16;
typedef __attribute__((ext_vector_type(4))) unsigned u32x4;

#define NTHR 512
#define SMEM_BYTES 155648
constexpr int GT = 16384;
constexpr int TOK = 81920;

constexpr size_t SZ_WT_EVIN = 2ull * 9216 * 1024 * 2;
constexpr size_t SZ_WT_EVOUT = 2ull * 1024 * 2048 * 2;
constexpr size_t SZ_WT_ODIN = 2ull * 6144 * 1024 * 2;
constexpr size_t SZ_WT_ODOUT = 2ull * 1024 * 2048 * 2;
constexpr size_t SZ_WT_Q = 4ull * 1024 * 1024 * 2;
constexpr size_t SZ_WT_KV = 4ull * 2048 * 1024 * 2;
constexpr size_t SZ_WT_O = 4ull * 1024 * 1024 * 2;
constexpr size_t SZ_KM = 4ull * 2304 * 1024 * 2;
constexpr size_t SZ_ROPE = 16384ull * 128 * 8;
constexpr size_t SZ_TW = 16384ull * 8;
constexpr size_t SZ_G = 16384ull * 16 * 4;
constexpr size_t SZ_NV = 128ull * 4 * 2 * 256 * 4;
constexpr size_t SZ_CS = 128ull * 4 * 4 * 4;
constexpr size_t SZ_MS = 128ull * 4 * 2 * 4;

constexpr size_t OFF_WT_EVIN = 0;
constexpr size_t OFF_WT_EVOUT = OFF_WT_EVIN + SZ_WT_EVIN;
constexpr size_t OFF_WT_ODIN = OFF_WT_EVOUT + SZ_WT_EVOUT;
constexpr size_t OFF_WT_ODOUT = OFF_WT_ODIN + SZ_WT_ODIN;
constexpr size_t OFF_WT_Q = OFF_WT_ODOUT + SZ_WT_ODOUT;
constexpr size_t OFF_WT_KV = OFF_WT_Q + SZ_WT_Q;
constexpr size_t OFF_WT_O = OFF_WT_KV + SZ_WT_KV;
constexpr size_t OFF_KM = OFF_WT_O + SZ_WT_O;
constexpr size_t OFF_VTM = OFF_KM + SZ_KM;
constexpr size_t OFF_ROPE = OFF_VTM + SZ_KM;
constexpr size_t OFF_TW = OFF_ROPE + SZ_ROPE;
constexpr size_t OFF_G = OFF_TW + SZ_TW;
constexpr size_t OFF_NV = OFF_G + SZ_G;
constexpr size_t OFF_CS = OFF_NV + SZ_NV;
constexpr size_t OFF_MS = OFF_CS + SZ_CS;
constexpr size_t OFF_W3T = OFF_MS + SZ_MS;
constexpr size_t OFF_R = OFF_W3T + 2ull * 2048 * 64 * 2;
constexpr size_t R_P = OFF_R;
constexpr size_t R_VT = R_P + 16384ull * 6144 * 2;
constexpr size_t R_X1T = R_VT + 1024ull * 16384 * 2;
constexpr size_t R_VHT = R_X1T + 1024ull * 16384 * 2;
constexpr size_t R_QP = R_VHT + 1024ull * 16384 * 2;
constexpr size_t R_KP = R_QP + 1024ull * 16384 * 2;
constexpr size_t R_Y = R_KP + 1024ull * 16384 * 2;
constexpr size_t R_ST = R_Y + 16384ull * 2048 * 2;
constexpr size_t R_CT = R_ST + 1024ull * 65536 * 2;
constexpr size_t R_HK = R_CT + 1024ull * 16384 * 4;
constexpr size_t OFF_BAR = R_HK + 1024ull * 32768 * 4;
constexpr size_t WS_NEED = OFF_BAR + 16384;

struct Params {
  const float* in[32];
  float* out;
  char* ws;
};

__device__ __forceinline__ u16 f2bf(float f) { unsigned u = __float_as_uint(f); u += 0x7fffu + ((u >> 16) & 1u); return (u16)(u >> 16); }
__device__ __forceinline__ float bf2f(u16 h) { return __uint_as_float(((unsigned)h) << 16); }
__device__ __forceinline__ unsigned pack2(float a, float b) { return (unsigned)f2bf(a) | ((unsigned)f2bf(b) << 16); }
__device__ __forceinline__ float siluf(float x) { return x / (1.f + __expf(-x)); }
__device__ __forceinline__ float sigmf(float x) { return 1.f / (1.f + __expf(-x)); }
__device__ __forceinline__ float logsig(float x) { return fminf(x, 0.f) - log1pf(__expf(-fabsf(x))); }
__device__ __forceinline__ int opaque(int x) { asm volatile("" : "+v"(x)); return x; }
__device__ __forceinline__ float wave_sum(float v) {
#pragma unroll
  for (int o = 32; o; o >>= 1) v += __shfl_xor(v, o);
  return v;
}
__device__ __forceinline__ void unpack8(const uint4& v, float (&f)[8]) {
  f[0] = __uint_as_float(v.x << 16); f[1] = __uint_as_float(v.x & 0xffff0000u);
  f[2] = __uint_as_float(v.y << 16); f[3] = __uint_as_float(v.y & 0xffff0000u);
  f[4] = __uint_as_float(v.z << 16); f[5] = __uint_as_float(v.z & 0xffff0000u);
  f[6] = __uint_as_float(v.w << 16); f[7] = __uint_as_float(v.w & 0xffff0000u);
}
__device__ __forceinline__ uint4 pack8(const float (&f)[8]) {
  uint4 v; v.x = pack2(f[0], f[1]); v.y = pack2(f[2], f[3]); v.z = pack2(f[4], f[5]); v.w = pack2(f[6], f[7]); return v;
}
__device__ __forceinline__ const float* xrow_in(const Params& p, int layer, int tok) {
  if (layer == 0) return (tok < 16384) ? (p.in[0] + (size_t)tok * 1024) : (p.in[1] + (size_t)(tok - 16384) * 1024);
  return p.out + (size_t)tok * 1024;
}
__device__ __forceinline__ int seq_of_tok(int tok) { return tok < 16384 ? 0 : 1 + ((tok - 16384) >> 13); }

__device__ __forceinline__ void gload4(bf16x8& f0, bf16x8& f1, bf16x8& f2, bf16x8& f3, const u16* p) {
  asm volatile("global_load_dwordx4 %0, %4, off\n\tglobal_load_dwordx4 %1, %4, off offset:16\n\t"
               "global_load_dwordx4 %2, %4, off offset:32\n\tglobal_load_dwordx4 %3, %4, off offset:48"
               : "=&v"(f0), "=&v"(f1), "=&v"(f2), "=&v"(f3) : "v"(p) : "memory");
}
__device__ __forceinline__ void vmwait0() { asm volatile("s_waitcnt vmcnt(0)" ::: "memory"); }
__device__ __forceinline__ void touch(bf16x8& f) { asm volatile("" : "+v"(f)); }
__device__ __forceinline__ void gload2(bf16x8& f0, bf16x8& f1, const u16* p) {
  asm volatile("global_load_dwordx4 %0, %2, off\n\tglobal_load_dwordx4 %1, %2, off offset:16"
               : "=&v"(f0), "=&v"(f1) : "v"(p) : "memory");
}
template <int MT, int NT_, bool AG>
__device__ __forceinline__ void wave_mma_g(f32x16 (&acc)[MT][NT_], const u16* A, int lda, const u16* B, int ldb, int K) {
  constexpr int J = (MT >= 4) ? 2 : 4;
  constexpr int KB = 16 * J;
  const int lane = opaque((int)threadIdx.x) & 63;
  const u16* ap = A + (size_t)(lane & 31) * lda + (lane >> 5) * (8 * J);
  const u16* bp = B + (size_t)(lane & 31) * ldb + (lane >> 5) * (8 * J);
#pragma unroll 1
  for (int kb = 0; kb < K; kb += KB) {
    bf16x8 a[MT][J], b[NT_][J];
#pragma unroll
    for (int ni = 0; ni < NT_; ++ni) {
      if (J == 4) gload4(b[ni][0], b[ni][1], b[ni][J - 2], b[ni][J - 1], bp + (size_t)ni * 32 * ldb + kb);
      else gload2(b[ni][0], b[ni][1], bp + (size_t)ni * 32 * ldb + kb);
    }
    if (AG) {
#pragma unroll
      for (int mi = 0; mi < MT; ++mi) {
        if (J == 4) gload4(a[mi][0], a[mi][1], a[mi][J - 2], a[mi][J - 1], ap + (size_t)mi * 32 * lda + kb);
        else gload2(a[mi][0], a[mi][1], ap + (size_t)mi * 32 * lda + kb);
      }
    } else {
#pragma unroll
      for (int mi = 0; mi < MT; ++mi)
#pragma unroll
        for (int j = 0; j < J; ++j) a[mi][j] = *(const bf16x8*)(ap + (size_t)mi * 32 * lda + kb + j * 8);
    }
    vmwait0();
#pragma unroll
    for (int ni = 0; ni < NT_; ++ni)
#pragma unroll
      for (int j = 0; j < J; ++j) touch(b[ni][j]);
    if (AG) {
#pragma unroll
      for (int mi = 0; mi < MT; ++mi)
#pragma unroll
        for (int j = 0; j < J; ++j) touch(a[mi][j]);
    }
#pragma unroll
    for (int j = 0; j < J; ++j)
#pragma unroll
      for (int mi = 0; mi < MT; ++mi)
#pragma unroll
        for (int ni = 0; ni < NT_; ++ni)
          acc[mi][ni] = __builtin_amdgcn_mfma_f32_32x32x16_bf16(a[mi][j], b[ni][j], acc[mi][ni], 0, 0, 0);
  }
}
template <int MT, int NT_>
__device__ __forceinline__ void zero_acc(f32x16 (&acc)[MT][NT_]) {
#pragma unroll
  for (int mi = 0; mi < MT; ++mi)
#pragma unroll
    for (int ni = 0; ni < NT_; ++ni)
#pragma unroll
      for (int r = 0; r < 16; ++r) acc[mi][ni][r] = 0.f;
}

#ifndef GEMM_NI
#define GEMM_NI 4
#endif
template <int NI, class E>
__device__ __forceinline__ void gemm_stream(const u16* __restrict__ A, int lda, const u16* __restrict__ BT, int ldb, int K, int M, int N,
                                            char* smem, const E& epi) {
  constexpr int BN = 64 * NI;
  constexpr int NBL = NI;
  u16* As = (u16*)smem;
  u16* Bs = As + 2 * 256 * 72;
  const int tid = opaque((int)threadIdx.x), lane = tid & 63, w = tid >> 6, wm = w >> 1, wn = w & 1;
  const int ntm = M >> 8, ntn = N / BN, ntiles = ntm * ntn;
  int t = blockIdx.x;
  if (t >= ntiles) return;
  const int nk = K >> 6;
  const int lr = tid >> 3, lc = (tid & 7) * 8;
  int tn = t / ntm, tm = t - tn * ntm;
  unsigned aoff = (unsigned)(tm * 256 + lr) * (unsigned)lda + lc;
  unsigned boff = (unsigned)(tn * BN + lr) * (unsigned)ldb + lc;
  {
    uint4 pa[4], pb[NBL];
#pragma unroll
    for (int i = 0; i < 4; ++i) pa[i] = *(const uint4*)(A + aoff + (unsigned)(64 * i) * lda);
#pragma unroll
    for (int i = 0; i < NBL; ++i) pb[i] = *(const uint4*)(BT + boff + (unsigned)(64 * i) * ldb);
#pragma unroll
    for (int i = 0; i < 4; ++i) *(uint4*)(As + (lr + 64 * i) * 72 + lc) = pa[i];
#pragma unroll
    for (int i = 0; i < NBL; ++i) *(uint4*)(Bs + (lr + 64 * i) * 72 + lc) = pb[i];
  }
  __syncthreads();
  int cur = 0;
  while (true) {
    f32x16 acc[2][NI];
    zero_acc<2, NI>(acc);
    const int tnext = t + gridDim.x;
    int tn2 = tn, tm2 = tm;
    if (tnext < ntiles) { tn2 = tnext / ntm; tm2 = tnext - tn2 * ntm; }
    const unsigned aoff2 = (unsigned)(tm2 * 256 + lr) * (unsigned)lda + lc;
    const unsigned boff2 = (unsigned)(tn2 * BN + lr) * (unsigned)ldb + lc;
    for (int kt = 0; kt < nk; ++kt) {
      const bool last = (kt + 1 == nk);
      const unsigned an = last ? aoff2 : aoff + (kt + 1) * 64;
      const unsigned bn = last ? boff2 : boff + (kt + 1) * 64;
      u32x4 ra[4], rb[NBL];
#pragma unroll
      for (int i = 0; i < 4; ++i) {
        const u16* gp = A + an + (unsigned)(64 * i) * lda;
        asm volatile("global_load_dwordx4 %0, %1, off" : "=&v"(ra[i]) : "v"(gp) : "memory");
      }
#pragma unroll
      for (int i = 0; i < NBL; ++i) {
        const u16* gp = BT + bn + (unsigned)(64 * i) * ldb;
        asm volatile("global_load_dwordx4 %0, %1, off" : "=&v"(rb[i]) : "v"(gp) : "memory");
      }
      const u16* as = As + cur * 256 * 72 + (wm * 64 + (lane & 31)) * 72 + (lane >> 5) * 8;
      const u16* bs = Bs + cur * BN * 72 + (wn * 32 * NI + (lane & 31)) * 72 + (lane >> 5) * 8;
#pragma unroll
      for (int ks = 0; ks < 4; ++ks) {
        bf16x8 a[2], b[NI];
#pragma unroll
        for (int mi = 0; mi < 2; ++mi) a[mi] = *(const bf16x8*)(as + mi * 32 * 72 + ks * 16);
#pragma unroll
        for (int ni = 0; ni < NI; ++ni) b[ni] = *(const bf16x8*)(bs + ni * 32 * 72 + ks * 16);
#pragma unroll
        for (int mi = 0; mi < 2; ++mi)
#pragma unroll
          for (int ni = 0; ni < NI; ++ni)
            acc[mi][ni] = __builtin_amdgcn_mfma_f32_32x32x16_bf16(a[mi], b[ni], acc[mi][ni], 0, 0, 0);
      }
      asm volatile("s_waitcnt vmcnt(0)" ::: "memory");
#pragma unroll
      for (int i = 0; i < 4; ++i) asm volatile("" : "+v"(ra[i]));
#pragma unroll
      for (int i = 0; i < NBL; ++i) asm volatile("" : "+v"(rb[i]));
      {
        const int nx = cur ^ 1;
#pragma unroll
        for (int i = 0; i < 4; ++i) *(u32x4*)(As + nx * 256 * 72 + (lr + 64 * i) * 72 + lc) = ra[i];
#pragma unroll
        for (int i = 0; i < NBL; ++i) *(u32x4*)(Bs + nx * BN * 72 + (lr + 64 * i) * 72 + lc) = rb[i];
      }
      __syncthreads();
      cur ^= 1;
    }
    {
      const int lane_e = opaque(lane);
      const int row0 = tm * 256, col0 = tn * BN;
      const int li4 = lane_e & 3;
#pragma unroll
      for (int ni = 0; ni < NI; ++ni) {
        const int colb = col0 + wn * 32 * NI + ni * 32;
        if (epi.transposed(colb)) {
#pragma unroll
          for (int mi = 0; mi < 2; ++mi)
#pragma unroll
            for (int q = 0; q < 4; ++q) {
              const int row = row0 + wm * 64 + mi * 32 + 8 * q + 4 * (lane_e >> 5);
              epi.t(row, colb + (lane_e & 31), acc[mi][ni][4 * q], acc[mi][ni][4 * q + 1], acc[mi][ni][4 * q + 2], acc[mi][ni][4 * q + 3]);
            }
        } else {
#pragma unroll
          for (int mi = 0; mi < 2; ++mi)
#pragma unroll
            for (int q = 0; q < 4; ++q) {
              float v0 = acc[mi][ni][4 * q], v1 = acc[mi][ni][4 * q + 1], v2 = acc[mi][ni][4 * q + 2], v3 = acc[mi][ni][4 * q + 3];
              {
                const bool od = li4 & 1;
                const float r0 = __shfl_xor(od ? v0 : v1, 1), r1 = __shfl_xor(od ? v2 : v3, 1);
                if (od) { v0 = r0; v2 = r1; } else { v1 = r0; v3 = r1; }
              }
              {
                const bool hi = li4 & 2;
                const float r0 = __shfl_xor(hi ? v0 : v2, 2), r1 = __shfl_xor(hi ? v1 : v3, 2);
                if (hi) { v0 = r0; v1 = r1; } else { v2 = r0; v3 = r1; }
              }
              const int row = row0 + wm * 64 + mi * 32 + 8 * q + 4 * (lane_e >> 5) + li4;
              epi.r(row, colb + ((lane_e & 31) & ~3), v0, v1, v2, v3);
            }
        }
      }
    }
    if (tnext >= ntiles) break;
    t = tnext; tn = tn2; tm = tm2; aoff = aoff2; boff = boff2;
  }
}

template <class E>
__device__ __forceinline__ void gemm_phase(const u16* A, int lda, const u16* BT, int ldb, int K, int M, int N, char* smem, const E& epi) {
  gemm_stream<GEMM_NI>(A, lda, BT, ldb, K, M, N, smem, epi);
  __syncthreads();
}

__device__ __forceinline__ void st4(u16* p, int ld, float v0, float v1, float v2, float v3) {
  p[0] = f2bf(v0); p[ld] = f2bf(v1); p[2 * ld] = f2bf(v2); p[3 * ld] = f2bf(v3);
}
__device__ __forceinline__ void st4t(u16* p, float v0, float v1, float v2, float v3) {
  uint2 u; u.x = pack2(v0, v1); u.y = pack2(v2, v3); *(uint2*)p = u;
}

__device__ __forceinline__ void st4r(u16* p, float v0, float v1, float v2, float v3) {
  uint2 u; u.x = pack2(v0, v1); u.y = pack2(v2, v3); *(uint2*)p = u;
}
struct EpiEvenIn {
  u16 *P, *VT, *X1T, *VHT;
  __device__ __forceinline__ bool transposed(int colb) const { const int seg = colb >> 10; return seg == 2 || seg == 6 || seg == 7; }
  __device__ __forceinline__ void t(int row, int col, float v0, float v1, float v2, float v3) const {
    const int seg = col >> 10, c = col & 1023;
    const int idx = (seg == 2) ? 0 : (seg - 5);
    st4t(VT + (size_t)idx * 1024 * GT + (size_t)c * GT + row, v0, v1, v2, v3);
  }
  __device__ __forceinline__ void r(int row, int col, float v0, float v1, float v2, float v3) const {
    const int seg = col >> 10;
    const int pc = (seg < 2) ? col : (seg < 6 ? col - 1024 : col - 3072);
    st4r(P + (size_t)row * 6144 + pc, v0, v1, v2, v3);
  }
};
struct EpiOddIn {
  u16 *P, *VT;
  __device__ __forceinline__ bool transposed(int colb) const { const int seg = colb >> 10; return seg == 2 || seg == 3; }
  __device__ __forceinline__ void t(int row, int col, float v0, float v1, float v2, float v3) const {
    st4t(VT + (size_t)(col - 2048) * GT + row, v0, v1, v2, v3);
  }
  __device__ __forceinline__ void r(int row, int col, float v0, float v1, float v2, float v3) const {
    const int pc = (col < 2048) ? col : col - 2048;
    st4r(P + (size_t)row * 4096 + pc, v0, v1, v2, v3);
  }
};
struct EpiResid {
  Params p; int layer; int tokbase;
  __device__ __forceinline__ bool transposed(int) const { return false; }
  __device__ __forceinline__ void t(int, int, float, float, float, float) const {}
  __device__ __forceinline__ void r(int row, int col, float v0, float v1, float v2, float v3) const {
    const int tok = tokbase + row;
    const float* xb = xrow_in(p, layer, tokbase);
    const float4 x = *(const float4*)(xb + (size_t)row * 1024 + col);
    *(float4*)(p.out + (size_t)tok * 1024 + col) = make_float4(x.x + v0, x.y + v1, x.z + v2, x.w + v3);
  }
};
struct EpiPlain {
  u16* C; int ldc;
  __device__ __forceinline__ bool transposed(int) const { return false; }
  __device__ __forceinline__ void t(int, int, float, float, float, float) const {}
  __device__ __forceinline__ void r(int row, int col, float v0, float v1, float v2, float v3) const {
    st4r(C + (size_t)row * ldc + col, v0, v1, v2, v3);
  }
};
struct EpiKV {
  u16 *KM, *VTM;
  __device__ __forceinline__ bool transposed(int colb) const { return colb >= 1024; }
  __device__ __forceinline__ void t(int row, int col, float v0, float v1, float v2, float v3) const {
    st4t(VTM + ((size_t)(row >> 8) * 1024 + (col - 1024)) * 256 + (row & 255), v0, v1, v2, v3);
  }
  __device__ __forceinline__ void r(int row, int col, float v0, float v1, float v2, float v3) const {
    st4r(KM + (size_t)row * 1024 + col, v0, v1, v2, v3);
  }
};

__device__ void tc_matrix(const float* __restrict__ src, int ld, int col0, int K, int N, u16* __restrict__ dst, char* smem) {
  float* lds = (float*)smem;
  const int tid = threadIdx.x;
  const int tn = N >> 6, tk = K >> 6;
  for (int t = blockIdx.x; t < tn * tk; t += gridDim.x) {
    const int k0 = (t / tn) << 6, n0 = (t % tn) << 6;
    float tv[8];
#pragma unroll
    for (int i = 0; i < 8; ++i) {
      const int e = tid + i * 512, kk = e >> 6, nn = e & 63;
      tv[i] = src[(size_t)(k0 + kk) * ld + col0 + n0 + nn];
    }
    asm volatile("" ::: "memory");
#pragma unroll
    for (int i = 0; i < 8; ++i) {
      const int e = tid + i * 512, kk = e >> 6, nn = e & 63;
      lds[kk * 65 + nn] = tv[i];
    }
    __syncthreads();
    const int n = tid >> 3, kq = tid & 7;
    float f[8];
#pragma unroll
    for (int j = 0; j < 8; ++j) f[j] = lds[(kq * 8 + j) * 65 + n];
    *(uint4*)(dst + (size_t)(n0 + n) * K + k0 + kq * 8) = pack8(f);
    __syncthreads();
  }
}

__device__ __forceinline__ void norm_row(const float* __restrict__ x, const float* __restrict__ g, u16* __restrict__ o, float (&hn)[16], const int lane) {
  float4 v[4];
  float ss = 0.f;
#pragma unroll
  for (int i = 0; i < 4; ++i) {
    v[i] = *(const float4*)(x + i * 256 + lane * 4);
    ss += v[i].x * v[i].x + v[i].y * v[i].y + v[i].z * v[i].z + v[i].w * v[i].w;
  }
  ss = wave_sum(ss);
  const float r = rsqrtf(ss * (1.f / 1024.f) + 1e-6f);
#pragma unroll
  for (int i = 0; i < 4; ++i) {
    const float4 gg = *(const float4*)(g + i * 256 + lane * 4);
    hn[i * 4 + 0] = v[i].x * r * gg.x; hn[i * 4 + 1] = v[i].y * r * gg.y;
    hn[i * 4 + 2] = v[i].z * r * gg.z; hn[i * 4 + 3] = v[i].w * r * gg.w;
    uint2 u; u.x = pack2(hn[i * 4], hn[i * 4 + 1]); u.y = pack2(hn[i * 4 + 2], hn[i * 4 + 3]);
    *(uint2*)(o + i * 256 + lane * 4) = u;
  }
}

template <int R, class XF, class OF, class KF>
__device__ __forceinline__ void norm_rows(XF xf, const float* __restrict__ g, OF of, KF okf, float (&hn)[R][16], const int lane) {
  float4 v[R][4];
#pragma unroll
  for (int r = 0; r < R; ++r) {
    const float* x = xf(r);
#pragma unroll
    for (int i = 0; i < 4; ++i) v[r][i] = *(const float4*)(x + i * 256 + lane * 4);
  }
  float4 gg[4];
#pragma unroll
  for (int i = 0; i < 4; ++i) gg[i] = *(const float4*)(g + i * 256 + lane * 4);
#pragma unroll
  for (int r = 0; r < R; ++r) {
    float ss = 0.f;
#pragma unroll
    for (int i = 0; i < 4; ++i) ss += v[r][i].x * v[r][i].x + v[r][i].y * v[r][i].y + v[r][i].z * v[r][i].z + v[r][i].w * v[r][i].w;
    ss = wave_sum(ss);
    const float rs = rsqrtf(ss * (1.f / 1024.f) + 1e-6f);
    u16* o = of(r);
    const bool ok = okf(r);
#pragma unroll
    for (int i = 0; i < 4; ++i) {
      hn[r][i * 4 + 0] = v[r][i].x * rs * gg[i].x; hn[r][i * 4 + 1] = v[r][i].y * rs * gg[i].y;
      hn[r][i * 4 + 2] = v[r][i].z * rs * gg[i].z; hn[r][i * 4 + 3] = v[r][i].w * rs * gg[i].w;
      uint2 u; u.x = pack2(hn[r][i * 4], hn[r][i * 4 + 1]); u.y = pack2(hn[r][i * 4 + 2], hn[r][i * 4 + 3]);
      if (ok) *(uint2*)(o + i * 256 + lane * 4) = u;
    }
  }
}

__device__ __forceinline__ float2 cmul(float2 a, float2 b) { return make_float2(a.x * b.x - a.y * b.y, a.x * b.y + a.y * b.x); }
__device__ __forceinline__ float2 twid(float x) {
  return make_float2(__builtin_amdgcn_cosf(x), -__builtin_amdgcn_sinf(x));
}
__device__ __forceinline__ float2 cadd(float2 a, float2 b) { return make_float2(a.x + b.x, a.y + b.y); }
__device__ __forceinline__ float2 csub(float2 a, float2 b) { return make_float2(a.x - b.x, a.y - b.y); }
__device__ void fft_fwd(float2* buf, int logM) {
  const int nq = 1 << (logM - 2);
  int s = logM - 1;
  for (; s >= 1; s -= 2) {
    const int q = 1 << (s - 1);
    const float invn = 1.f / (float)(4 * q);
    for (int t = threadIdx.x; t < nq; t += NTHR) {
      const int j = t & (q - 1), i0 = ((t >> (s - 1)) << (s + 1)) + j;
      const float2 a0 = buf[i0], a1 = buf[i0 + q], a2 = buf[i0 + 2 * q], a3 = buf[i0 + 3 * q];
      const float2 w1 = twid((float)j * invn);
      const float2 w1p = make_float2(w1.y, -w1.x);
      const float2 w2 = cmul(w1, w1);
      const float2 c0 = cadd(a0, a2), c2 = cmul(csub(a0, a2), w1);
      const float2 c1 = cadd(a1, a3), c3 = cmul(csub(a1, a3), w1p);
      buf[i0] = cadd(c0, c1);
      buf[i0 + q] = cmul(csub(c0, c1), w2);
      buf[i0 + 2 * q] = cadd(c2, c3);
      buf[i0 + 3 * q] = cmul(csub(c2, c3), w2);
    }
    __syncthreads();
  }
  if (s == 0) {
    for (int t = threadIdx.x; t < (1 << (logM - 1)); t += NTHR) {
      const float2 u = buf[2 * t], v = buf[2 * t + 1];
      buf[2 * t] = cadd(u, v);
      buf[2 * t + 1] = csub(u, v);
    }
    __syncthreads();
  }
}
__device__ void fft_inv(float2* buf, int logM) {
  const int nq = 1 << (logM - 2);
  int s = 0;
  if (logM & 1) {
    for (int t = threadIdx.x; t < (1 << (logM - 1)); t += NTHR) {
      const float2 u = buf[2 * t], v = buf[2 * t + 1];
      buf[2 * t] = cadd(u, v);
      buf[2 * t + 1] = csub(u, v);
    }
    __syncthreads();
    s = 1;
  }
  for (; s < logM; s += 2) {
    const int q = 1 << s;
    const float invn = 1.f / (float)(4 * q);
    for (int t = threadIdx.x; t < nq; t += NTHR) {
      const int j = t & (q - 1), i0 = ((t >> s) << (s + 2)) + j;
      const float2 x0 = buf[i0], x1 = buf[i0 + q], x2 = buf[i0 + 2 * q], x3 = buf[i0 + 3 * q];
      float2 w1 = twid((float)j * invn); w1.y = -w1.y;
      const float2 w2 = cmul(w1, w1);
      const float2 w1p = make_float2(-w1.y, w1.x);
      const float2 t1 = cmul(x1, w2), t3 = cmul(x3, w2);
      const float2 y0 = cadd(x0, t1), y1 = csub(x0, t1), y2 = cadd(x2, t3), y3 = csub(x2, t3);
      const float2 u2 = cmul(y2, w1), u3 = cmul(y3, w1p);
      buf[i0] = cadd(y0, u2);
      buf[i0 + 2 * q] = csub(y0, u2);
      buf[i0 + q] = cadd(y1, u3);
      buf[i0 + 3 * q] = csub(y1, u3);
    }
    __syncthreads();
  }
}
__device__ __forceinline__ int brev(int k, int logM) { return (int)(__brev((unsigned)k) >> (32 - logM)); }

struct Grp { int g, nb, L, ncs, logL; };
__device__ __forceinline__ Grp mk_grp(int g) {
  Grp r; r.g = g; r.nb = g == 0 ? 1 : 2; r.L = GT / r.nb; r.ncs = r.L >> 7; r.logL = g == 0 ? 14 : 13; return r;
}

__device__ void chunk_gates(const float* __restrict__ G, const float* __restrict__ bias, int lt0, int h, float* sg) {
  const int tid = threadIdx.x, lane = tid & 63, w = tid >> 6;
  float pf = 0.f, sb = 0.f;
  if (tid < 128) {
    const float* gr = G + (size_t)(lt0 + tid) * 16;
    sg[256 + tid] = gr[h] + bias[h];
    pf = logsig(gr[4 + h] + bias[4 + h]);
    sg[384 + tid] = gr[8 + h] + bias[8 + h];
    sb = logsig(gr[12 + h] + bias[12 + h]);
#pragma unroll
    for (int o = 1; o < 64; o <<= 1) {
      const float t1 = __shfl_up(pf, o), t2 = __shfl_down(sb, o);
      if (lane >= o) pf += t1;
      if (lane + o < 64) sb += t2;
    }
    if (lane == 63) sg[512 + w] = pf;
    if (lane == 0) sg[514 + w] = sb;
  }
  __syncthreads();
  if (tid < 128) {
    if (w == 1) pf += sg[512];
    if (w == 0) sb += sg[515];
    sg[tid] = pf; sg[128 + tid] = sb;
  }
  __syncthreads();
}

#define XB_TMO      128
#define XB_XCNT(j)  (256  + 64 * (j))
#define XB_XSUB(j)  (1280 + 64 * (j))
#define XB_XGEN(j)  (2304 + 64 * (j))
#define XB_TOP      3328
#define XB_TOPGEN   3392
#define XCD_BAR_WORDS 3456
#define XB_SPIN_CAP (1u << 18)
#define LAS __attribute__((address_space(3)))

__device__ __forceinline__ unsigned xb_ld(unsigned* p)              { return __hip_atomic_load(p, __ATOMIC_RELAXED, __HIP_MEMORY_SCOPE_AGENT); }
__device__ __forceinline__ unsigned xb_add(unsigned* p, unsigned v) { return __hip_atomic_fetch_add(p, v, __ATOMIC_RELAXED, __HIP_MEMORY_SCOPE_AGENT); }
__device__ __forceinline__ unsigned xb_xcc_id() { return (unsigned)__builtin_amdgcn_s_getreg((3 << 11) | 20) & 0xFu; }
#define XB_SPIN(cond, bar) do { unsigned _sp = 0; while (cond) { __builtin_amdgcn_s_sleep(1); \
    if ((++_sp & 255u) == 0u) { if (xb_ld(&(bar)[XB_TMO])) break; if (_sp > XB_SPIN_CAP) { atomicAdd(&(bar)[XB_TMO], 1u); break; } } } } while (0)

struct XcdBarrier {
    unsigned* bar; unsigned x;
    volatile LAS unsigned* st;
};

__device__ __forceinline__ XcdBarrier xcd_barrier_post(unsigned* bar, volatile LAS unsigned* st) {
    XcdBarrier b; b.bar = bar; b.x = xb_xcc_id(); b.st = st;
    if (threadIdx.x == 0) (void)xb_add(&bar[XB_XCNT(b.x)], 1u);
    return b;
}
__device__ __forceinline__ void xcd_barrier_complete(unsigned* bar, unsigned x, unsigned& nloc, unsigned& nx) {
    const unsigned G = gridDim.x * gridDim.y * gridDim.z;
    unsigned sum, cnt, mine, sp = 0u;
    for (;;) {
        sum = 0u; cnt = 0u; mine = 0u;
#pragma unroll
        for (unsigned j = 0; j < 16; ++j) { const unsigned c = xb_ld(&bar[XB_XCNT(j)]); sum += c; cnt += (c > 0u) ? 1u : 0u; mine = (j == x) ? c : mine; }
        if (sum == G) break;
        __builtin_amdgcn_s_sleep(1);
        if ((++sp & 255u) == 0u) { if (xb_ld(&bar[XB_TMO])) break; if (sp > XB_SPIN_CAP) { atomicAdd(&bar[XB_TMO], 1u); break; } }
    }
    nloc = mine > 0u ? mine : 1u; nx = cnt > 0u ? cnt : 1u;
}

__device__ __attribute__((noinline)) void xcd_barrier(const XcdBarrier b) {
    asm volatile("s_waitcnt vmcnt(0)" ::: "memory");
    __syncthreads();
    if (threadIdx.x == 0) {
        unsigned* bar = b.bar;
        __builtin_amdgcn_s_waitcnt(0);
        unsigned nloc = b.st[0], nx = b.st[1];
        if (nloc == 0u) { xcd_barrier_complete(bar, b.x, nloc, nx); b.st[0] = nloc; b.st[1] = nx; }
        const unsigned old = xb_add(&bar[XB_XSUB(b.x)], 1u);
        const unsigned gen = old / nloc;
        if (old + 1u == (gen + 1u) * nloc) {
            __builtin_amdgcn_fence(__ATOMIC_RELEASE, "agent");
            asm volatile("s_waitcnt vmcnt(0)" ::: "memory");
            const unsigned og = xb_add(&bar[XB_TOP], 1u);
            const unsigned tg = og / nx;
            if (og + 1u == (tg + 1u) * nx) xb_add(&bar[XB_TOPGEN], 1u);
            else XB_SPIN(xb_ld(&bar[XB_TOPGEN]) == tg, bar);
            __builtin_amdgcn_fence(__ATOMIC_ACQUIRE, "agent");
            xb_add(&bar[XB_XGEN(b.x)], 1u);
            asm volatile("s_waitcnt vmcnt(0)" ::: "memory");
        } else {
            XB_SPIN(xb_ld(&bar[XB_XGEN(b.x)]) == gen, bar);
            __builtin_amdgcn_fence(__ATOMIC_ACQUIRE, "agent");
            asm volatile("s_waitcnt vmcnt(0)" ::: "memory");
        }
    }
    __syncthreads();
}


__global__ void __launch_bounds__(NTHR) fwd_kernel(Params p) {
  __shared__ __attribute__((aligned(16))) char smem[SMEM_BYTES];
  cg::grid_group grid = cg::this_grid();
  __shared__ uint4 xb_words;
  if (threadIdx.x == 0) xb_words = make_uint4(0u, 0u, 0u, 0u);
  __syncthreads();
  XcdBarrier xb = xcd_barrier_post((unsigned*)(p.ws + OFF_BAR), (volatile LAS unsigned*)&xb_words);
  const int nblk = gridDim.x, bid = blockIdx.x;
  char* ws = p.ws;
  u16* WT_EVIN = (u16*)(ws + OFF_WT_EVIN);
  u16* WT_EVOUT = (u16*)(ws + OFF_WT_EVOUT);
  u16* WT_ODIN = (u16*)(ws + OFF_WT_ODIN);
  u16* WT_ODOUT = (u16*)(ws + OFF_WT_ODOUT);
  u16* WT_Q = (u16*)(ws + OFF_WT_Q);
  u16* WT_KV = (u16*)(ws + OFF_WT_KV);
  u16* WT_O = (u16*)(ws + OFF_WT_O);
  u16* KM = (u16*)(ws + OFF_KM);
  u16* VTM = (u16*)(ws + OFF_VTM);
  float2* ROPE = (float2*)(ws + OFF_ROPE);
  float2* TW = (float2*)(ws + OFF_TW);
  float* Gt = (float*)(ws + OFF_G);
  float* NV = (float*)(ws + OFF_NV);
  float* CS = (float*)(ws + OFF_CS);
  float* MS = (float*)(ws + OFF_MS);
  u16* W3T = (u16*)(ws + OFF_W3T);
  u16* P = (u16*)(ws + R_P);
  u16* VT = (u16*)(ws + R_VT);
  u16* X1T = (u16*)(ws + R_X1T);
  u16* VHT = (u16*)(ws + R_VHT);
  u16* QP = (u16*)(ws + R_QP);
  u16* KP = (u16*)(ws + R_KP);
  u16* Y = (u16*)(ws + R_Y);
  u16* HN = Y;
  u16* ST = (u16*)(ws + R_ST);
  float* CT = (float*)(ws + R_CT);
  float* HK = (float*)(ws + R_HK);
  u16* MN = P;
  u16* HQ = P;
  u16* QC = VT;

  {
    const int tid = opaque((int)threadIdx.x), lane = tid & 63, w = tid >> 6; (void)lane; (void)w;
    tc_matrix(p.in[8], 9232, 0, 1024, 5120, WT_EVIN, smem);
    tc_matrix(p.in[8], 9232, 5136, 1024, 4096, WT_EVIN + (size_t)5120 * 1024, smem);
    tc_matrix(p.in[8] + (size_t)1024 * 9232, 9232, 0, 1024, 5120, WT_EVIN + (size_t)9216 * 1024, smem);
    tc_matrix(p.in[8] + (size_t)1024 * 9232, 9232, 5136, 1024, 4096, WT_EVIN + (size_t)9216 * 1024 + (size_t)5120 * 1024, smem);
    for (int i = 0; i < 2; ++i) {
      tc_matrix(p.in[24] + (size_t)i * 2048 * 1024, 1024, 0, 2048, 1024, WT_EVOUT + (size_t)i * 1024 * 2048, smem);
      tc_matrix(p.in[25] + (size_t)i * 1024 * 6144, 6144, 0, 1024, 6144, WT_ODIN + (size_t)i * 6144 * 1024, smem);
      tc_matrix(p.in[28] + (size_t)i * 2048 * 1024, 1024, 0, 2048, 1024, WT_ODOUT + (size_t)i * 1024 * 2048, smem);
    }
    for (int i = 0; i < 2; ++i) tc_matrix(p.in[21] + (size_t)i * 64 * 2048, 2048, 0, 64, 2048, W3T + (size_t)i * 2048 * 64, smem);
    for (int l = 0; l < 4; ++l) {
      tc_matrix(p.in[29] + (size_t)l * 1024 * 1024, 1024, 0, 1024, 1024, WT_Q + (size_t)l * 1024 * 1024, smem);
      tc_matrix(p.in[30] + (size_t)l * 1024 * 2048, 2048, 0, 1024, 2048, WT_KV + (size_t)l * 2048 * 1024, smem);
      tc_matrix(p.in[31] + (size_t)l * 1024 * 1024, 1024, 0, 1024, 1024, WT_O + (size_t)l * 1024 * 1024, smem);
    }
    for (int idx = bid * NTHR + tid; idx < 16384 * 128; idx += nblk * NTHR) {
      const int pos = idx >> 7, j = idx & 127;
      const float inv = powf(10000.f, -(float)(2 * j) / 256.f);
      const float ang = (float)pos * inv;
      double q = (double)ang * 0.15915494309189533577;
      q -= floor(q);
      float s, c;
      sincosf((float)(q * 6.283185307179586477), &s, &c);
      ROPE[idx] = make_float2(c, s);
    }
    for (int k = bid * NTHR + tid; k < 16384; k += nblk * NTHR) {
      const float x = (float)k * (1.f / 16384.f);
      TW[k] = make_float2(cospif(x), -sinpif(x));
    }
    for (int r = bid * 8 + w; r < 4 * 2304; r += nblk * 8) {
      const int l = r / 2304, m = r - l * 2304;
      const float* x = (m < 256) ? (p.in[2] + (size_t)m * 1024) : (p.in[3] + (size_t)(m - 256) * 1024);
      float hn[16];
      norm_row(x, p.in[6] + l * 1024, MN + (size_t)r * 1024, hn, lane);
    }
  }
  grid.sync();
  for (int l = 0; l < 4; ++l) {
    EpiKV e{KM + (size_t)l * 2304 * 1024, VTM + (size_t)l * 2304 * 1024};
    gemm_phase(MN + (size_t)l * 2304 * 1024, 1024, WT_KV + (size_t)l * 2048 * 1024, 1024, 1024, 2304, 2048, smem, e);
  }
  GSYNC();

  for (int layer = 0; layer < 4; ++layer) {
    const int li = layer >> 1;
    const bool even = (layer & 1) == 0;
    for (int g = 0; g < 5; ++g) {
      const Grp G = mk_grp(g);
      const int tok0 = g * GT;
      {
        const int tid = opaque((int)threadIdx.x), lane = tid & 63, w = tid >> 6; (void)lane; (void)w;
        const float* gmix = p.in[4] + layer * 1024;
        const float* Win = p.in[8] + (size_t)li * 1024 * 9232;
        const int S1 = nblk * 8;
        if (even) {
          for (int r = bid * 8 + w; r < GT; r += nblk * 8) {
            float hn[16];
            norm_row(xrow_in(p, layer, tok0 + r), gmix, HN + (size_t)r * 1024, hn, lane);
            float ga[16];
#pragma unroll
            for (int j = 0; j < 16; ++j) ga[j] = 0.f;
#pragma unroll
            for (int i = 0; i < 4; ++i)
#pragma unroll
              for (int e = 0; e < 4; ++e) {
                const float* wr = Win + (size_t)(i * 256 + lane * 4 + e) * 9232 + 5120;
                const float hv = hn[i * 4 + e];
#pragma unroll
                for (int q = 0; q < 4; ++q) {
                  const float4 wv = *(const float4*)(wr + q * 4);
                  ga[q * 4 + 0] += hv * wv.x; ga[q * 4 + 1] += hv * wv.y; ga[q * 4 + 2] += hv * wv.z; ga[q * 4 + 3] += hv * wv.w;
                }
              }
            float outv = 0.f;
#pragma unroll
            for (int j = 0; j < 16; ++j) { const float sm_ = wave_sum(ga[j]); if (lane == j) outv = sm_; }
            if (lane < 16) Gt[(size_t)r * 16 + lane] = outv;
          }
        } else {
          for (int r = bid * 8 + w; r < GT; r += 4 * S1) {
            float hn[4][16];
            norm_rows<4>([&](int k) { const int rr = r + k * S1; return xrow_in(p, layer, tok0 + (rr < GT ? rr : r)); }, gmix,
                         [&](int k) { const int rr = r + k * S1; return HN + (size_t)(rr < GT ? rr : r) * 1024; },
                         [&](int k) { return r + k * S1 < GT; }, hn, lane);
          }
        }
#ifndef NO_MLP
        if (even && g <= 1) {
          const int l_ = G.L;
          float* w1s = (float*)smem;
          float* w2s = (float*)(smem + 8448);
          float* fs = (float*)(smem + 24832);
          float* z1s = (float*)(smem + 41728);
          u16* Zb = (u16*)(smem + 74496);
          float* cst = (float*)(smem + 92928);
          const float* dl = p.in[22] + li * 2048;
          const u16* W3Tl = W3T + (size_t)li * 2048 * 64;
          __syncthreads();
          for (int e = tid; e < 33 * 64; e += NTHR) w1s[e] = p.in[15][li * 33 * 64 + e];
          for (int e = tid; e < 64 * 64; e += NTHR) w2s[e] = p.in[18][li * 64 * 64 + e];
          if (tid < 64) {
            cst[tid] = p.in[16][li * 64 + tid]; cst[64 + tid] = p.in[17][li * 64 + tid];
            cst[128 + tid] = p.in[19][li * 64 + tid]; cst[192 + tid] = p.in[20][li * 64 + tid];
          }
#ifdef PROBE_MLP
          for (int rep = 0; rep < 2; ++rep)
#endif
          for (int t = bid; t < (l_ >> 7) * 4; t += nblk) {
            const int j0 = (t >> 2) * 128, cq = t & 3;
            __syncthreads();
            for (int e = tid; e < 33 * 128; e += NTHR) {
              const int f = e >> 7, pp = e & 127;
              const int j = j0 + pp;
              float val;
              if (f == 0) val = (float)j / (float)(l_ - 1);
              else {
                const int b = (f - 1) & 15;
                const double band = 1e-4 + (double)b * ((15.0 - 1e-4) / 15.0);
                double q = band * (double)j / (double)l_;
                q -= floor(q);
                float sn, cs;
                sincosf((float)(q * 6.283185307179586477), &sn, &cs);
                val = (f <= 16) ? cs : -sn;
              }
              fs[e] = val;
            }
            __syncthreads();
            const int pp = tid & 127, kq = tid >> 7;
            {
              float a1[16];
#pragma unroll
              for (int j = 0; j < 16; ++j) a1[j] = cst[kq * 16 + j];
              for (int f = 0; f < 33; ++f) {
                const float x = fs[f * 128 + pp];
#pragma unroll
                for (int j = 0; j < 16; ++j) a1[j] += x * w1s[f * 64 + kq * 16 + j];
              }
#pragma unroll
              for (int j = 0; j < 16; ++j) z1s[(kq * 16 + j) * 128 + pp] = sinf(cst[64 + kq * 16 + j] * a1[j]);
            }
            __syncthreads();
            {
              float a2[16];
#pragma unroll
              for (int j = 0; j < 16; ++j) a2[j] = cst[128 + kq * 16 + j];
              for (int k = 0; k < 64; ++k) {
                const float x = z1s[k * 128 + pp];
#pragma unroll
                for (int j = 0; j < 16; ++j) a2[j] += x * w2s[k * 64 + kq * 16 + j];
              }
              float o[16];
#pragma unroll
              for (int j = 0; j < 16; ++j) o[j] = sinf(cst[192 + kq * 16 + j] * a2[j]);
              uint4 u0, u1;
              u0.x = pack2(o[0], o[1]); u0.y = pack2(o[2], o[3]); u0.z = pack2(o[4], o[5]); u0.w = pack2(o[6], o[7]);
              u1.x = pack2(o[8], o[9]); u1.y = pack2(o[10], o[11]); u1.z = pack2(o[12], o[13]); u1.w = pack2(o[14], o[15]);
              *(uint4*)(Zb + pp * 72 + kq * 16) = u0;
              *(uint4*)(Zb + pp * 72 + kq * 16 + 8) = u1;
            }
            __syncthreads();
            const float tden = 1.f / (float)(l_ - 1);
#pragma unroll 1
            for (int nt = cq * 2; nt < cq * 2 + 2; ++nt) {
              const int c = w * 256 + nt * 32 + (lane & 31);
              f32x16 acc[4][1];
              zero_acc<4, 1>(acc);
              wave_mma_g<4, 1, false>(acc, Zb, 72, W3Tl + (size_t)(w * 256 + nt * 32) * 64, 64, 64);
              const float ad = fabsf(dl[c]);
#pragma unroll
              for (int mi = 0; mi < 4; ++mi)
#pragma unroll
                for (int q = 0; q < 4; ++q) {
                  const int j = j0 + mi * 32 + 8 * q + 4 * (lane >> 5);
                  float v[4];
#pragma unroll
                  for (int e = 0; e < 4; ++e) v[e] = acc[mi][0][4 * q + e] * (__expf(-(float)(j + e) * tden * ad) + 0.05f);
                  if (c < 1024) *(float4*)(HK + (size_t)c * 32768 + j) = make_float4(v[0], v[1], v[2], v[3]);
                  else {
                    float* rowp = HK + (size_t)(c - 1024) * 32768;
#pragma unroll
                    for (int e = 0; e < 4; ++e) { if (j + e == 0) rowp[l_] = 0.f; else rowp[2 * l_ - j - e] = v[e]; }
                  }
                }
            }
          }
          __syncthreads();
        }
#endif
      }
      GSYNC();
#ifndef NO_PH2
      if (even) {
        EpiEvenIn e{P, VT, X1T, VHT};
        gemm_phase(HN, 1024, WT_EVIN + (size_t)li * 9216 * 1024, 1024, 1024, GT, 9216, smem, e);
        if (g <= 1) {
          const int tid = opaque((int)threadIdx.x), lane = tid & 63, w = tid >> 6; (void)lane; (void)w;
          float2* buf = (float2*)smem;
          float* red = (float*)(smem + 131072);
          const int M = G.L, logM = G.logL;
          for (int c = bid; c < 1024; c += nblk) {
            float2* row = (float2*)(HK + (size_t)c * 32768);
            float l1 = 0.f;
            for (int n0 = tid; n0 < M; n0 += 8 * NTHR) {
              float2 v[8];
#pragma unroll
              for (int j = 0; j < 8; ++j) v[j] = row[n0 + j * NTHR];
              asm volatile("" ::: "memory");
#pragma unroll
              for (int j = 0; j < 8; ++j) { buf[n0 + j * NTHR] = v[j]; l1 += fabsf(v[j].x) + fabsf(v[j].y); }
            }
            l1 = wave_sum(l1);
            if (lane == 0) red[w] = l1;
            __syncthreads();
            float tot = 0.f;
#pragma unroll
            for (int i = 0; i < 8; ++i) tot += red[i];
            const float scale = 1.f / (tot * (float)M);
            fft_fwd(buf, logM);
            for (int k = tid; k <= (M >> 1); k += NTHR) {
              const float2 a = buf[brev(k, logM)], b = buf[brev((M - k) & (M - 1), logM)];
              const float2 E = make_float2(0.5f * (a.x + b.x), 0.5f * (a.y - b.y));
              const float2 O = make_float2(0.5f * (a.y + b.y), -0.5f * (a.x - b.x));
              const float2 wk = twid((float)k / (float)(2 * M));
              const float2 wo = cmul(wk, O);
              const float2 Xk = make_float2(E.x + wo.x, E.y + wo.y);
              const float2 Xm = make_float2(E.x - wo.x, -(E.y - wo.y));
              if (k == 0) row[0] = make_float2(Xk.x * scale, Xm.x * scale);
              else { row[k] = make_float2(Xk.x * scale, Xk.y * scale); row[M - k] = make_float2(Xm.x * scale, Xm.y * scale); }
            }
            __syncthreads();
          }
        }
      } else {
        EpiOddIn e{P, VT};
        gemm_phase(HN, 1024, WT_ODIN + (size_t)li * 6144 * 1024, 1024, 1024, GT, 6144, smem, e);
      }
#endif
      GSYNC();
#ifndef NO_PH3
      {
        const int tid = opaque((int)threadIdx.x), lane = tid & 63, w = tid >> 6; (void)lane; (void)w;
        u16* Kp = (u16*)smem;
        u16* KsT = (u16*)(smem + 67584);
        float* sg = (float*)(smem + 67584 + 69632);
        float* swt = sg + 768;
#ifdef PROBE_CHUNK3
        for (int rep = 0; rep < 2; ++rep)
#endif
        for (int t = bid; t < 128 * 4; t += nblk) {
          const int ck = t >> 2, h = t & 3;
          const int lt0 = ck * 128;
          const int c = ck % G.ncs, pos0 = c * 128;
          if (even) {
            chunk_gates(Gt, p.in[11] + li * 16, lt0, h, sg);
            const float btf = sg[127], btb = sg[128];
            if (tid < 128) {
              float gf = btf - sg[tid] + sg[256 + tid], gb = btb - sg[128 + tid] + sg[384 + tid];
#pragma unroll
              for (int o = 32; o; o >>= 1) { gf = fmaxf(gf, __shfl_xor(gf, o)); gb = fmaxf(gb, __shfl_xor(gb, o)); }
              if (lane == 0) { sg[516 + w] = gf; sg[518 + w] = gb; }
            }
            __syncthreads();
            const float mf = fmaxf(sg[516], sg[517]), mb = fmaxf(sg[518], sg[519]);
            if (tid < 128) {
              swt[tid] = __expf(btf - sg[tid] + sg[256 + tid] - mf);
              swt[128 + tid] = __expf(btb - sg[128 + tid] + sg[384 + tid] - mb);
            }
            if (tid == 0) { float* cs = CS + (size_t)(ck * 4 + h) * 4; cs[0] = btf; cs[1] = mf; cs[2] = btb; cs[3] = mb; }
            const float* cw = p.in[9] + (size_t)li * 3 * 2048; const float* cb = p.in[10] + li * 2048;
#pragma unroll 1
            for (int mat = 0; mat < 2; ++mat) {
              const int cc = (tid & 31) * 8;
              const int colp = mat * 1024 + h * 256 + cc;
              float w0[8], w1[8], w2[8], wb[8];
              *(float4*)&w0[0] = *(const float4*)(cw + colp); *(float4*)&w0[4] = *(const float4*)(cw + colp + 4);
              *(float4*)&w1[0] = *(const float4*)(cw + 2048 + colp); *(float4*)&w1[4] = *(const float4*)(cw + 2048 + colp + 4);
              *(float4*)&w2[0] = *(const float4*)(cw + 4096 + colp); *(float4*)&w2[4] = *(const float4*)(cw + 4096 + colp + 4);
              *(float4*)&wb[0] = *(const float4*)(cb + colp); *(float4*)&wb[4] = *(const float4*)(cb + colp + 4);
#pragma unroll 1
              for (int bt = 0; bt < 2; ++bt) {
                uint4 vc[4], vp[4], vn[4];
#pragma unroll
                for (int k = 0; k < 4; ++k) {
                  const int r = (tid >> 5) + (bt * 4 + k) * 16;
                  const int pos = pos0 + r;
                  const u16* src = P + (size_t)(lt0 + r) * 6144 + colp;
                  vc[k] = *(const uint4*)src;
                  vp[k] = *(const uint4*)(pos > 0 ? src - 6144 : src);
                  vn[k] = *(const uint4*)(pos < G.L - 1 ? src + 6144 : src);
                }
                asm volatile("" ::: "memory");
#pragma unroll
                for (int k = 0; k < 4; ++k) {
                  const int r = (tid >> 5) + (bt * 4 + k) * 16;
                  const int pos = pos0 + r;
                  float xc[8], xp[8], xn[8], o[8];
                  unpack8(vc[k], xc); unpack8(vp[k], xp); unpack8(vn[k], xn);
                  const float mp = pos > 0 ? 1.f : 0.f, mn_ = pos < G.L - 1 ? 1.f : 0.f;
#pragma unroll
                  for (int j = 0; j < 8; ++j) {
                    const float v = w0[j] * (xp[j] * mp) + w1[j] * xc[j] + w2[j] * (xn[j] * mn_) + wb[j];
                    o[j] = siluf(v) * (mat ? 0.0625f : 1.f);
                  }
                  const uint4 pk = pack8(o);
                  if (mat == 0) *(uint4*)(QP + (size_t)(lt0 + r) * 1024 + h * 256 + cc) = pk;
                  else { *(uint4*)(KP + (size_t)(lt0 + r) * 1024 + h * 256 + cc) = pk; *(uint4*)(Kp + r * 264 + cc) = pk; }
                }
              }
            }
          } else {
            const float* dlg = p.in[26] + li * 8;
            const float lgf = logsig(dlg[h]), lgb = logsig(dlg[4 + h]);
            if (tid < 128) { swt[tid] = __expf(lgf * (float)(127 - tid)); swt[128 + tid] = __expf(lgb * (float)tid); }
#pragma unroll 1
            for (int mat = 0; mat < 2; ++mat) {
              for (int e = tid; e < 128 * 16; e += NTHR) {
                const int r = e >> 4, cc = (e & 15) * 8;
                const int pos = pos0 + r;
                const u16* src = P + (size_t)(lt0 + r) * 4096 + mat * 1024 + h * 256 + cc;
                float x1[8], x2[8], o1[8], o2[8];
                unpack8(*(const uint4*)src, x1);
                unpack8(*(const uint4*)(src + 128), x2);
                const float2* rp = ROPE + (size_t)pos * 128 + cc;
                const float sc = mat ? 1.f : 0.0625f;
#pragma unroll
                for (int j = 0; j < 8; ++j) {
                  const float2 cs = rp[j];
                  o1[j] = (x1[j] * cs.x - x2[j] * cs.y) * sc;
                  o2[j] = (x1[j] * cs.y + x2[j] * cs.x) * sc;
                }
                const uint4 p1 = pack8(o1), p2 = pack8(o2);
                u16* dst = (mat == 0 ? QP : KP) + (size_t)(lt0 + r) * 1024 + h * 256 + cc;
                *(uint4*)dst = p1; *(uint4*)(dst + 128) = p2;
                if (mat) { *(uint4*)(Kp + r * 264 + cc) = p1; *(uint4*)(Kp + r * 264 + cc + 128) = p2; }
              }
            }
          }
          __syncthreads();
          for (int dir = 0; dir < 2; ++dir) {
            for (int e = tid; e < 256 * 16; e += NTHR) {
              const int d = e & 255, sc = e >> 8;
              float f[8];
#pragma unroll
              for (int j = 0; j < 8; ++j) f[j] = bf2f(Kp[(sc * 8 + j) * 264 + d]) * swt[dir * 128 + sc * 8 + j];
              *(uint4*)(KsT + d * 136 + sc * 8) = pack8(f);
            }
            __syncthreads();
            const int wm = w >> 1, wn = w & 1;
            const int nvh = even ? 1 : 2;
            for (int vh = 0; vh < nvh * 2; ++vh) {
              const int nh = vh & 1, vq = vh >> 1;
              const int lane_o = opaque(lane);
              f32x16 acc[2][2];
              zero_acc<2, 2>(acc);
              const int vrow0 = even ? (h * 256) : (h * 512 + vq * 256);
              wave_mma_g<2, 2, false>(acc, KsT + (wm * 64) * 136, 136, VT + (size_t)(vrow0 + wn * 128 + nh * 64) * GT + lt0, GT, 128);
              u16* stp = even ? (ST + ((size_t)((ck * 4 + h) * 2 + dir) << 16))
                              : (ST + ((size_t)((ck * 4 + h) * 2 + dir) << 17) + (size_t)vq * 65536);
              const int hh_o = lane_o >> 5;
#pragma unroll
              for (int mi = 0; mi < 2; ++mi)
#pragma unroll
                for (int ni = 0; ni < 2; ++ni)
#pragma unroll
                  for (int pq = 0; pq < 2; ++pq) {
                    const unsigned e0 = pack2(acc[mi][ni][8 * pq], acc[mi][ni][8 * pq + 1]), e1 = pack2(acc[mi][ni][8 * pq + 2], acc[mi][ni][8 * pq + 3]);
                    const unsigned o0 = pack2(acc[mi][ni][8 * pq + 4], acc[mi][ni][8 * pq + 5]), o1 = pack2(acc[mi][ni][8 * pq + 6], acc[mi][ni][8 * pq + 7]);
                    const unsigned s0 = hh_o ? e0 : o0, s1 = hh_o ? e1 : o1;
                    const unsigned r0 = (unsigned)__shfl_xor((int)s0, 32), r1 = (unsigned)__shfl_xor((int)s1, 32);
                    uint4 u;
                    if (hh_o) { u.x = r0; u.y = r1; u.z = o0; u.w = o1; } else { u.x = e0; u.y = e1; u.z = r0; u.w = r1; }
                    const int d0 = wm * 64 + mi * 32 + 16 * pq + 8 * hh_o;
                    const int v = wn * 128 + nh * 64 + ni * 32 + (lane_o & 31);
                    *(uint4*)(stp + v * 256 + d0) = u;
                  }
            }
            if (even && tid < 256) {
              float a = 0.f;
              for (int s = 0; s < 128; ++s) a += bf2f(KsT[tid * 136 + s]);
              NV[(size_t)((ck * 4 + h) * 2 + dir) * 256 + tid] = a;
            }
            __syncthreads();
          }
        }
      }
#endif
      GSYNC();
#ifndef NO_PH4
      {
        const int tid = opaque((int)threadIdx.x), lane = tid & 63, w = tid >> 6; (void)lane; (void)w;
        const int nchain = G.nb * 4 * 2;
        if (even) {
#pragma unroll 1
          for (int pass = 0; pass < 2; ++pass) {
          if ((pass == 0) == ((bid & 8) == 0)) {
          for (int it = bid * NTHR + tid; it < nchain * 16384; it += nblk * NTHR) {
            const int ch = it >> 14, e = it & 16383;
            const int bl = ch >> 3, h = (ch >> 1) & 3, dir = ch & 1;
            float c0 = 0.f, c1 = 0.f, c2 = 0.f, c3 = 0.f, m = 0.f;
            for (int cc0 = 0; cc0 < G.ncs; cc0 += 8) {
              uint2 u[8];
              uint2* ptr[8];
              float2 csv[8];
#pragma unroll
              for (int j = 0; j < 8; ++j) {
                const int ck = bl * G.ncs + (dir ? G.ncs - 1 - (cc0 + j) : (cc0 + j));
                ptr[j] = (uint2*)(ST + ((size_t)((ck * 4 + h) * 2 + dir) << 16)) + e;
                u[j] = *ptr[j];
                csv[j] = *(const float2*)(CS + (size_t)(ck * 4 + h) * 4 + dir * 2);
              }
#pragma unroll
              for (int j = 0; j < 8; ++j) {
                const float bt = csv[j].x, ml = csv[j].y;
                const float mn = fmaxf(bt + m, ml);
                const float a = __expf(bt + m - mn), b = __expf(ml - mn);
                uint2 o; o.x = pack2(c0, c1); o.y = pack2(c2, c3);
                *ptr[j] = o;
                c0 = a * c0 + b * __uint_as_float(u[j].x << 16); c1 = a * c1 + b * __uint_as_float(u[j].x & 0xffff0000u);
                c2 = a * c2 + b * __uint_as_float(u[j].y << 16); c3 = a * c3 + b * __uint_as_float(u[j].y & 0xffff0000u);
                m = mn;
              }
            }
          }
          for (int it = bid * NTHR + tid; it < nchain * 256; it += nblk * NTHR) {
            const int ch = it >> 8, d = it & 255;
            const int bl = ch >> 3, h = (ch >> 1) & 3, dir = ch & 1;
            float c0 = 0.f, m = 0.f;
            for (int cc0 = 0; cc0 < G.ncs; cc0 += 8) {
              float u[8];
              float* ptr[8];
              float2 csv[8];
#pragma unroll
              for (int j = 0; j < 8; ++j) {
                const int ck = bl * G.ncs + (dir ? G.ncs - 1 - (cc0 + j) : (cc0 + j));
                ptr[j] = NV + (size_t)((ck * 4 + h) * 2 + dir) * 256 + d;
                u[j] = *ptr[j];
                csv[j] = *(const float2*)(CS + (size_t)(ck * 4 + h) * 4 + dir * 2);
              }
#pragma unroll
              for (int j = 0; j < 8; ++j) {
                const int ck = bl * G.ncs + (dir ? G.ncs - 1 - (cc0 + j) : (cc0 + j));
                const float bt = csv[j].x, ml = csv[j].y;
                const float mn = fmaxf(bt + m, ml);
                const float a = __expf(bt + m - mn), b = __expf(ml - mn);
                *ptr[j] = c0;
                if (d == 0) MS[(ck * 4 + h) * 2 + dir] = m;
                c0 = a * c0 + b * u[j];
                m = mn;
              }
            }
          }
          } else
          {
            float2* buf = (float2*)smem;
            const int M = G.L, logM = G.logL;
            const float* hcw = p.in[13] + (size_t)li * 3 * 3072; const float* hcb = p.in[14] + li * 3072;
            const float* skp = p.in[23] + li * 1024;
#ifdef PROBE_FFT
            for (int rep = 0; rep < 2; ++rep)
#endif
            for (int t = bid; t < G.nb * 1024; t += nblk) {
              const int bl = t >> 10, c = t & 1023;
              const u16* x1r = X1T + (size_t)c * GT + bl * M;
              const u16* vhr = VHT + (size_t)c * GT + bl * M;
              const float a0 = hcw[1024 + c], a1 = hcw[3072 + 1024 + c], a2 = hcw[6144 + 1024 + c], ab = hcb[1024 + c];
              const float v0 = hcw[2048 + c], v1 = hcw[3072 + 2048 + c], v2 = hcw[6144 + 2048 + c], vb = hcb[2048 + c];
              const float skip = skp[c];
              const float2* Hr = (const float2*)(HK + (size_t)c * 32768);
              for (int n8 = tid; n8 < (M >> 3); n8 += NTHR) {
                const int j0 = n8 * 8;
                float xa[8], xv[8], tt[8];
                unpack8(*(const uint4*)(x1r + j0), xa);
                unpack8(*(const uint4*)(vhr + j0), xv);
                const float pa = j0 > 0 ? bf2f(x1r[j0 - 1]) : 0.f, na = j0 + 8 < M ? bf2f(x1r[j0 + 8]) : 0.f;
                const float pv = j0 > 0 ? bf2f(vhr[j0 - 1]) : 0.f, nv = j0 + 8 < M ? bf2f(vhr[j0 + 8]) : 0.f;
#pragma unroll
                for (int j = 0; j < 8; ++j) {
                  const float xl = j ? xa[j - 1] : pa, xr = j < 7 ? xa[j + 1] : na;
                  const float vl = j ? xv[j - 1] : pv, vr = j < 7 ? xv[j + 1] : nv;
                  tt[j] = (a0 * xl + a1 * xa[j] + a2 * xr + ab) * (v0 * vl + v1 * xv[j] + v2 * vr + vb);
                }
#pragma unroll
                for (int q = 0; q < 4; ++q) buf[n8 * 4 + q] = make_float2(tt[2 * q], tt[2 * q + 1]);
              }
              for (int n = (M >> 1) + tid; n < M; n += NTHR) buf[n] = make_float2(0.f, 0.f);
              __syncthreads();
              fft_fwd(buf, logM);
              for (int k0 = tid; k0 <= (M >> 1); k0 += 4 * NTHR) {
                float2 hk[4], hm[4];
#pragma unroll
                for (int jb = 0; jb < 4; ++jb) {
                  const int k = min(k0 + jb * NTHR, M >> 1);
                  hk[jb] = Hr[k]; hm[jb] = Hr[(M - k) & (M - 1)];
                }
                asm volatile("" ::: "memory");
#pragma unroll
                for (int jb = 0; jb < 4; ++jb) {
                const int k = k0 + jb * NTHR;
                if (k <= (M >> 1)) {
                const int ia = brev(k, logM), ib = brev((M - k) & (M - 1), logM);
                const float2 a = buf[ia], b = buf[ib];
                const float2 E = make_float2(0.5f * (a.x + b.x), 0.5f * (a.y - b.y));
                const float2 O = make_float2(0.5f * (a.y + b.y), -0.5f * (a.x - b.x));
                const float2 wk = twid((float)k / (float)(2 * M));
                const float2 wo = cmul(wk, O);
                const float2 Xk = make_float2(E.x + wo.x, E.y + wo.y);
                const float2 Xm = make_float2(E.x - wo.x, -(E.y - wo.y));
                float2 Yk, Ym;
                if (k == 0) { const float2 h0 = hk[jb]; Yk = make_float2(Xk.x * h0.x, 0.f); Ym = make_float2(Xm.x * h0.y, 0.f); }
                else { Yk = cmul(Xk, hk[jb]); Ym = cmul(Xm, hm[jb]); }
                const float2 E2 = make_float2(0.5f * (Yk.x + Ym.x), 0.5f * (Yk.y - Ym.y));
                const float2 Dd = make_float2(0.5f * (Yk.x - Ym.x), 0.5f * (Yk.y + Ym.y));
                const float2 O2 = cmul(make_float2(wk.x, -wk.y), Dd);
                buf[ia] = make_float2(E2.x - O2.y, E2.y + O2.x);
                if (k != 0) buf[ib] = make_float2(E2.x + O2.y, -E2.y + O2.x);
                }
                }
              }
              __syncthreads();
              fft_inv(buf, logM);
              float* ctr = CT + (size_t)c * GT + bl * M;
              for (int n8 = tid; n8 < (M >> 3); n8 += NTHR) {
                const int j0 = n8 * 8;
                float xa[8], xv[8], o[8];
                unpack8(*(const uint4*)(x1r + j0), xa);
                unpack8(*(const uint4*)(vhr + j0), xv);
                const float pa = j0 > 0 ? bf2f(x1r[j0 - 1]) : 0.f, na = j0 + 8 < M ? bf2f(x1r[j0 + 8]) : 0.f;
                const float pv = j0 > 0 ? bf2f(vhr[j0 - 1]) : 0.f, nv = j0 + 8 < M ? bf2f(vhr[j0 + 8]) : 0.f;
#pragma unroll
                for (int j = 0; j < 8; ++j) {
                  const float xl = j ? xa[j - 1] : pa, xr = j < 7 ? xa[j + 1] : na;
                  const float vl = j ? xv[j - 1] : pv, vr = j < 7 ? xv[j + 1] : nv;
                  const float tv = (a0 * xl + a1 * xa[j] + a2 * xr + ab) * (v0 * vl + v1 * xv[j] + v2 * vr + vb);
                  const float2 z = buf[n8 * 4 + (j >> 1)];
                  o[j] = ((j & 1) ? z.y : z.x) + skip * tv;
                }
                *(float4*)(ctr + j0) = make_float4(o[0], o[1], o[2], o[3]);
                *(float4*)(ctr + j0 + 4) = make_float4(o[4], o[5], o[6], o[7]);
              }
              __syncthreads();
            }
          }
          }
        } else {
          const float* dlg = p.in[26] + li * 8;
          for (int it = bid * NTHR + tid; it < nchain * 32768; it += nblk * NTHR) {
            const int ch = it >> 15, e = it & 32767;
            const int bl = ch >> 3, h = (ch >> 1) & 3, dir = ch & 1;
            const float a = __expf(128.f * logsig(dlg[dir * 4 + h]));
            float c0 = 0.f, c1 = 0.f, c2 = 0.f, c3 = 0.f;
            for (int cc0 = 0; cc0 < G.ncs; cc0 += 8) {
              uint2 u[8];
              uint2* ptr[8];
#pragma unroll
              for (int j = 0; j < 8; ++j) {
                const int ck = bl * G.ncs + (dir ? G.ncs - 1 - (cc0 + j) : (cc0 + j));
                ptr[j] = (uint2*)(ST + ((size_t)((ck * 4 + h) * 2 + dir) << 17)) + e;
                u[j] = *ptr[j];
              }
#pragma unroll
              for (int j = 0; j < 8; ++j) {
                uint2 o; o.x = pack2(c0, c1); o.y = pack2(c2, c3);
                *ptr[j] = o;
                c0 = a * c0 + __uint_as_float(u[j].x << 16); c1 = a * c1 + __uint_as_float(u[j].x & 0xffff0000u);
                c2 = a * c2 + __uint_as_float(u[j].y << 16); c3 = a * c3 + __uint_as_float(u[j].y & 0xffff0000u);
              }
            }
          }
        }
      }
#endif
      GSYNC();
#ifndef NO_PH5
      {
        const int tid = opaque((int)threadIdx.x), lane = tid & 63, w = tid >> 6; (void)lane; (void)w;
        float* Ss = (float*)smem;
        u16* Ps = (u16*)(smem + 33792);
        u16* Qf = (u16*)(smem + 33792 + 17408);
        u16* Qb = (u16*)(smem + 33792 + 17408 + 33792);
        float* Os = (float*)smem;
        float* sg = (float*)(smem + 135168);
        float* snf = sg + 768;
        float* sq = snf + 512;
#ifdef PROBE_CHUNK5
        for (int rep = 0; rep < 2; ++rep)
#endif
        const bool paired = (nblk == 256);
        for (int t = paired ? ((((bid >> 3) >> 1) << 3) + (bid & 7)) : bid; t < 128 * 4; t += (paired ? 128 : nblk)) {
          const int ck = t >> 2, h = t & 3;
          const int lt0 = ck * 128;
          const int tid_o = tid;
          const int wm = w >> 2, wn = w & 3;
          const int row = tid_o >> 3, sub = tid_o & 7;
          float lgf = 0.f, lgb = 0.f, mstf = 0.f, mstb = 0.f;
          if (even) {
            chunk_gates(Gt, p.in[11] + li * 16, lt0, h, sg);
            snf[tid] = NV[(size_t)((ck * 4 + h) * 2 + (tid >> 8)) * 256 + (tid & 255)];
            mstf = MS[(ck * 4 + h) * 2]; mstb = MS[(ck * 4 + h) * 2 + 1];
            __syncthreads();
          } else {
            const float* dlg = p.in[26] + li * 8;
            lgf = logsig(dlg[h]); lgb = logsig(dlg[4 + h]);
          }
#pragma unroll 1
          for (int half = paired ? ((bid >> 3) & 1) : 0; half < (paired ? (((bid >> 3) & 1) + 1) : 2); ++half) {
          const int ltr = lt0 + half * 64;
          const int tau = half * 64 + row;
          {
            const int tidf = opaque(tid); const int lane = tidf & 63, wq_ = tidf >> 6, wm = wq_ >> 2, wn = wq_ & 3, row = tidf >> 3, sub = tidf & 7; const int tau = half * 64 + row; (void)lane; (void)wm; (void)wn; (void)row; (void)sub; (void)tau;
            f32x16 acc[1][1];
            zero_acc<1, 1>(acc);
            wave_mma_g<1, 1, true>(acc, QP + (size_t)(ltr + wm * 32) * 1024 + h * 256, 1024, KP + (size_t)(lt0 + wn * 32) * 1024 + h * 256, 1024, 256);
#pragma unroll
            for (int r = 0; r < 16; ++r) {
              const int rr = wm * 32 + (r & 3) + 8 * (r >> 2) + 4 * (lane >> 5);
              Ss[rr * 132 + wn * 32 + (lane & 31)] = acc[0][0][r];
            }
          }
          if (even) {
            const int tidf = opaque(tid); const int lane = tidf & 63, wq_ = tidf >> 6, wm = wq_ >> 2, wn = wq_ & 3, row = tidf >> 3, sub = tidf & 7; const int tau = half * 64 + row; (void)lane; (void)wm; (void)wn; (void)row; (void)sub; (void)tau;
            const u16* qr = QP + (size_t)(ltr + row) * 1024 + h * 256 + sub * 32;
            float sf = 0.f, sb = 0.f;
#pragma unroll
            for (int q4 = 0; q4 < 4; ++q4) {
              float f[8];
              unpack8(*(const uint4*)(qr + q4 * 8), f);
#pragma unroll
              for (int j = 0; j < 8; ++j) { sf += f[j] * snf[sub * 32 + q4 * 8 + j]; sb += f[j] * snf[256 + sub * 32 + q4 * 8 + j]; }
            }
            sf += __shfl_xor(sf, 1); sf += __shfl_xor(sf, 2); sf += __shfl_xor(sf, 4);
            sb += __shfl_xor(sb, 1); sb += __shfl_xor(sb, 2); sb += __shfl_xor(sb, 4);
            if (sub == 0) { sq[row] = sf; sq[64 + row] = sb; }
          }
          __syncthreads();
          {
            const int tidf = opaque(tid); const int lane = tidf & 63, wq_ = tidf >> 6, wm = wq_ >> 2, wn = wq_ & 3, row = tidf >> 3, sub = tidf & 7; const int tau = half * 64 + row; (void)lane; (void)wm; (void)wn; (void)row; (void)sub; (void)tau;
            float pf[16], pb[16];
            float af, ab;
            if (even) {
              const float bcf = sg[tau], bcb = sg[128 + tau];
              float mf = -1e30f, mb = -1e30f;
#pragma unroll
              for (int j = 0; j < 16; ++j) {
                const int s = sub * 16 + j;
                if (s <= tau) mf = fmaxf(mf, bcf - sg[s] + sg[256 + s]);
                if (s >= tau) mb = fmaxf(mb, bcb - sg[128 + s] + sg[384 + s]);
              }
              mf = fmaxf(mf, __shfl_xor(mf, 1)); mf = fmaxf(mf, __shfl_xor(mf, 2)); mf = fmaxf(mf, __shfl_xor(mf, 4));
              mb = fmaxf(mb, __shfl_xor(mb, 1)); mb = fmaxf(mb, __shfl_xor(mb, 2)); mb = fmaxf(mb, __shfl_xor(mb, 4));
              const float interf = bcf + mstf, interb = bcb + mstb;
              mf = fmaxf(mf, interf); mb = fmaxf(mb, interb);
              float sumf = 0.f, sumb = 0.f;
#pragma unroll
              for (int j = 0; j < 16; ++j) {
                const int s = sub * 16 + j;
                const float sv = Ss[row * 132 + s];
                pf[j] = (s <= tau) ? sv * __expf(bcf - sg[s] + sg[256 + s] - mf) : 0.f;
                pb[j] = (s >= tau) ? sv * __expf(bcb - sg[128 + s] + sg[384 + s] - mb) : 0.f;
                sumf += pf[j]; sumb += pb[j];
              }
              sumf += __shfl_xor(sumf, 1); sumf += __shfl_xor(sumf, 2); sumf += __shfl_xor(sumf, 4);
              sumb += __shfl_xor(sumb, 1); sumb += __shfl_xor(sumb, 2); sumb += __shfl_xor(sumb, 4);
              const float scf = __expf(interf - mf), scb = __expf(interb - mb);
              const float denf = sumf + scf * sq[row], denb = sumb + scb * sq[64 + row];
              const float nf = fmaxf(fabsf(denf), __expf(-mf)), nbv = fmaxf(fabsf(denb), __expf(-mb));
              const float inf_ = 1.f / nf, inb = 1.f / nbv;
              af = scf * inf_; ab = scb * inb;
#pragma unroll
              for (int j = 0; j < 16; ++j) pf[j] = pf[j] * inf_ + pb[j] * inb;
            } else {
#pragma unroll
              for (int j = 0; j < 16; ++j) {
                const int s = sub * 16 + j;
                const float sv = Ss[row * 132 + s];
                float wgt = 0.f;
                if (s <= tau) wgt += __expf(lgf * (float)(tau - s));
                if (s >= tau) wgt += __expf(lgb * (float)(s - tau));
                pf[j] = sv * wgt;
              }
              af = __expf(lgf * (float)(tau + 1)); ab = __expf(lgb * (float)(128 - tau));
            }
            uint4 u0, u1;
            u0.x = pack2(pf[0], pf[1]); u0.y = pack2(pf[2], pf[3]); u0.z = pack2(pf[4], pf[5]); u0.w = pack2(pf[6], pf[7]);
            u1.x = pack2(pf[8], pf[9]); u1.y = pack2(pf[10], pf[11]); u1.z = pack2(pf[12], pf[13]); u1.w = pack2(pf[14], pf[15]);
            *(uint4*)(Ps + row * 136 + sub * 16) = u0;
            *(uint4*)(Ps + row * 136 + sub * 16 + 8) = u1;
            if (sub == 0) { sq[128 + row] = af; sq[192 + row] = ab; }
          }
          __syncthreads();
          uint4 qv[4];
          {
            const int e0 = opaque(tid);
#pragma unroll
            for (int it = 0; it < 4; ++it) {
              const int e = e0 + it * NTHR;
              qv[it] = *(const uint4*)(QP + (size_t)(ltr + (e >> 5)) * 1024 + h * 256 + (e & 31) * 8);
            }
            asm volatile("" ::: "memory");
          }
          for (int e = opaque(tid), it = 0; e < 64 * 32; e += NTHR, ++it) {
            const int r = e >> 5, cc = (e & 31) * 8;
            float f[8], o1[8], o2[8];
            unpack8(it == 0 ? qv[0] : (it == 1 ? qv[1] : (it == 2 ? qv[2] : qv[3])), f);
            const float a1 = sq[128 + r], a2 = sq[192 + r];
#pragma unroll
            for (int j = 0; j < 8; ++j) { o1[j] = f[j] * a1; o2[j] = f[j] * a2; }
            *(uint4*)(Qf + r * 264 + cc) = pack8(o1);
            *(uint4*)(Qb + r * 264 + cc) = pack8(o2);
          }
          __syncthreads();
          if (even) {
            const int tidf = opaque(tid); const int lane = tidf & 63, wq_ = tidf >> 6, wm = wq_ >> 2, wn = wq_ & 3, row = tidf >> 3, sub = tidf & 7; const int tau = half * 64 + row; (void)lane; (void)wm; (void)wn; (void)row; (void)sub; (void)tau;
            f32x16 acc[1][2];
            zero_acc<1, 2>(acc);
            const u16* stf = ST + ((size_t)((ck * 4 + h) * 2) << 16);
            const u16* stb = stf + 65536;
            wave_mma_g<1, 2, false>(acc, Ps + wm * 32 * 136, 136, VT + (size_t)(h * 256 + wn * 64) * GT + lt0, GT, 128);
            wave_mma_g<1, 2, false>(acc, Qf + wm * 32 * 264, 264, stf + (size_t)(wn * 64) * 256, 256, 256);
            wave_mma_g<1, 2, false>(acc, Qb + wm * 32 * 264, 264, stb + (size_t)(wn * 64) * 256, 256, 256);
#ifdef PROBE_OGEMM
            {
              f32x16 accd[1][2];
              zero_acc<1, 2>(accd);
              wave_mma_g<1, 2, false>(accd, Ps + wm * 32 * 136, 136, VT + (size_t)(h * 256 + wn * 64) * GT + lt0, GT, 128);
              wave_mma_g<1, 2, false>(accd, Qf + wm * 32 * 264, 264, stf + (size_t)(wn * 64) * 256, 256, 256);
              wave_mma_g<1, 2, false>(accd, Qb + wm * 32 * 264, 264, stb + (size_t)(wn * 64) * 256, 256, 256);
              if (p.ws == nullptr) {
#pragma unroll
                for (int ni = 0; ni < 2; ++ni)
#pragma unroll
                  for (int r = 0; r < 16; ++r) acc[0][ni][r] += accd[0][ni][r];
              }
            }
#endif
            __syncthreads();
#pragma unroll
            for (int ni = 0; ni < 2; ++ni)
#pragma unroll
              for (int r = 0; r < 16; ++r) {
                const int rr = wm * 32 + (r & 3) + 8 * (r >> 2) + 4 * (lane >> 5);
                Os[rr * 260 + wn * 64 + ni * 32 + (lane & 31)] = acc[0][ni][r];
              }
            __syncthreads();
            {
            const int tidf = opaque(tid); const int lane = tidf & 63, wq_ = tidf >> 6, wm = wq_ >> 2, wn = wq_ & 3, row = tidf >> 3, sub = tidf & 7; const int tau = half * 64 + row; (void)lane; (void)wm; (void)wn; (void)row; (void)sub; (void)tau;
            float s1 = 0.f;
#pragma unroll
            for (int j = 0; j < 32; ++j) s1 += Os[row * 260 + (j >> 3) * 64 + sub * 8 + (j & 7)];
            s1 += __shfl_xor(s1, 1); s1 += __shfl_xor(s1, 2); s1 += __shfl_xor(s1, 4);
            const float mu = s1 * (1.f / 256.f);
            float s2 = 0.f;
#pragma unroll
            for (int j = 0; j < 32; ++j) { const float d = Os[row * 260 + (j >> 3) * 64 + sub * 8 + (j & 7)] - mu; s2 += d * d; }
            s2 += __shfl_xor(s2, 1); s2 += __shfl_xor(s2, 2); s2 += __shfl_xor(s2, 4);
            const float rstd = rsqrtf(s2 * (1.f / 256.f) + 1e-5f);
            const float* gn = p.in[12] + li * 1024 + h * 256;
            const u16* prow = P + (size_t)(ltr + row) * 6144;
            uint4 voa[4], vza[4];
            float4 vg[4][2];
#pragma unroll
            for (int jj = 0; jj < 4; ++jj) {
              const int v = jj * 64 + sub * 8;
              voa[jj] = *(const uint4*)(prow + 2048 + h * 256 + v);
              vza[jj] = *(const uint4*)(prow + 3072 + h * 256 + v);
              vg[jj][0] = *(const float4*)(gn + v); vg[jj][1] = *(const float4*)(gn + v + 4);
            }
            asm volatile("" ::: "memory");
#pragma unroll
            for (int jj = 0; jj < 4; ++jj) {
              const int v = jj * 64 + sub * 8;
              float oa[8], za[8], o[8];
              unpack8(voa[jj], oa);
              unpack8(vza[jj], za);
              const float gv[8] = {vg[jj][0].x, vg[jj][0].y, vg[jj][0].z, vg[jj][0].w, vg[jj][1].x, vg[jj][1].y, vg[jj][1].z, vg[jj][1].w};
#pragma unroll
              for (int j = 0; j < 8; ++j)
                o[j] = (Os[row * 260 + v + j] - mu) * rstd * gv[j] * sigmf(oa[j]) * siluf(za[j]);
              *(uint4*)(Y + (size_t)(ltr + row) * 2048 + h * 256 + v) = pack8(o);
            }
            }
          } else {
            const int tidf = opaque(tid); const int lane = tidf & 63, wq_ = tidf >> 6, wm = wq_ >> 2, wn = wq_ & 3, row = tidf >> 3, sub = tidf & 7; const int tau = half * 64 + row; (void)lane; (void)wm; (void)wn; (void)row; (void)sub; (void)tau;

            f32x16 acc[1][4];
            zero_acc<1, 4>(acc);
            const u16* stf = ST + ((size_t)((ck * 4 + h) * 2) << 17);
            const u16* stb = stf + 131072;
            wave_mma_g<1, 4, false>(acc, Ps + wm * 32 * 136, 136, VT + (size_t)(h * 512 + wn * 128) * GT + lt0, GT, 128);
            wave_mma_g<1, 4, false>(acc, Qf + wm * 32 * 264, 264, stf + (size_t)(wn * 128) * 256, 256, 256);
            wave_mma_g<1, 4, false>(acc, Qb + wm * 32 * 264, 264, stb + (size_t)(wn * 128) * 256, 256, 256);
#ifdef PROBE_OGEMM
            {
              f32x16 accd[1][4];
              zero_acc<1, 4>(accd);
              wave_mma_g<1, 4, false>(accd, Ps + wm * 32 * 136, 136, VT + (size_t)(h * 512 + wn * 128) * GT + lt0, GT, 128);
              wave_mma_g<1, 4, false>(accd, Qf + wm * 32 * 264, 264, stf + (size_t)(wn * 128) * 256, 256, 256);
              wave_mma_g<1, 4, false>(accd, Qb + wm * 32 * 264, 264, stb + (size_t)(wn * 128) * 256, 256, 256);
              if (p.ws == nullptr) {
#pragma unroll
                for (int ni = 0; ni < 4; ++ni)
#pragma unroll
                  for (int r = 0; r < 16; ++r) acc[0][ni][r] += accd[0][ni][r];
              }
            }
#endif
            __syncthreads();
#pragma unroll
            for (int ni = 0; ni < 4; ++ni)
#pragma unroll
              for (int r = 0; r < 16; ++r) {
                const int rr = wm * 32 + (r & 3) + 8 * (r >> 2) + 4 * (lane >> 5);
                Os[rr * 516 + wn * 128 + ni * 32 + (lane & 31)] = acc[0][ni][r];
              }
            __syncthreads();
            {
            const int tidf = opaque(tid); const int lane = tidf & 63, wq_ = tidf >> 6, wm = wq_ >> 2, wn = wq_ & 3, row = tidf >> 3, sub = tidf & 7; const int tau = half * 64 + row; (void)lane; (void)wm; (void)wn; (void)row; (void)sub; (void)tau;
            float s1 = 0.f;
#pragma unroll
            for (int j = 0; j < 64; ++j) s1 += Os[row * 516 + (j >> 3) * 64 + sub * 8 + (j & 7)];
            s1 += __shfl_xor(s1, 1); s1 += __shfl_xor(s1, 2); s1 += __shfl_xor(s1, 4);
            const float mu = s1 * (1.f / 512.f);
            float s2 = 0.f;
#pragma unroll
            for (int j = 0; j < 64; ++j) { const float d = Os[row * 516 + (j >> 3) * 64 + sub * 8 + (j & 7)] - mu; s2 += d * d; }
            s2 += __shfl_xor(s2, 1); s2 += __shfl_xor(s2, 2); s2 += __shfl_xor(s2, 4);
            const float rstd = rsqrtf(s2 * (1.f / 512.f) + 1e-5f);
            const float* gn = p.in[27] + li * 2048 + h * 512;
            const u16* prow = P + (size_t)(ltr + row) * 4096 + 2048 + h * 512;
#pragma unroll 1
            for (int jb = 0; jb < 2; ++jb) {
              uint4 vgg[4];
              float4 vg[4][2];
#pragma unroll
              for (int j4 = 0; j4 < 4; ++j4) {
                const int v = (jb * 4 + j4) * 64 + sub * 8;
                vgg[j4] = *(const uint4*)(prow + v);
                vg[j4][0] = *(const float4*)(gn + v); vg[j4][1] = *(const float4*)(gn + v + 4);
              }
              asm volatile("" ::: "memory");
#pragma unroll
              for (int j4 = 0; j4 < 4; ++j4) {
                const int v = (jb * 4 + j4) * 64 + sub * 8;
                float gg[8], o[8];
                unpack8(vgg[j4], gg);
                const float gv[8] = {vg[j4][0].x, vg[j4][0].y, vg[j4][0].z, vg[j4][0].w, vg[j4][1].x, vg[j4][1].y, vg[j4][1].z, vg[j4][1].w};
#pragma unroll
                for (int j = 0; j < 8; ++j) o[j] = (Os[row * 516 + v + j] - mu) * rstd * gv[j] * siluf(gg[j]);
                *(uint4*)(Y + (size_t)(ltr + row) * 2048 + h * 512 + v) = pack8(o);
              }
            }
            }
          }
          __syncthreads();
          }
        }
        if (even) {
          float* lds = (float*)smem;
          const float* hcw = p.in[13] + (size_t)li * 3 * 3072; const float* hcb = p.in[14] + li * 3072;
#ifdef PROBE_FIN
          for (int rep = 0; rep < 2; ++rep)
#endif
          for (int t = bid; t < 256 * 16; t += nblk) {
            const int tt0 = (t >> 4) * 64, c0 = (t & 15) * 64;
            {
              float cv[8];
#pragma unroll
              for (int i = 0; i < 8; ++i) {
                const int e = tid + i * 512, c2 = e >> 6, tt = e & 63;
                cv[i] = CT[(size_t)(c0 + c2) * GT + tt0 + tt];
              }
              asm volatile("" ::: "memory");
#pragma unroll
              for (int i = 0; i < 8; ++i) {
                const int e = tid + i * 512, c2 = e >> 6, tt = e & 63;
                lds[c2 * 65 + tt] = cv[i];
              }
            }
            __syncthreads();
            {
              const int tq = opaque(tid);
              const int cc = tq & 63, c = c0 + cc, ttb = tq >> 6;
              const float w0 = hcw[c], w1 = hcw[3072 + c], w2 = hcw[6144 + c], wbb = hcb[c];
#pragma unroll 1
              for (int bt = 0; bt < 2; ++bt) {
                u16 rc[4], rp[4], rn[4], rz[4];
#pragma unroll
                for (int i = 0; i < 4; ++i) {
                  const int lt = tt0 + ttb + (bt * 4 + i) * 8;
                  const int pos = lt & (G.L - 1);
                  const u16* pr = P + (size_t)lt * 6144 + c;
                  rc[i] = pr[4096];
                  rp[i] = pr[4096 - (pos > 0 ? 6144 : 0)];
                  rn[i] = pr[4096 + (pos < G.L - 1 ? 6144 : 0)];
                  rz[i] = pr[5120];
                }
                asm volatile("" ::: "memory");
#pragma unroll
                for (int i = 0; i < 4; ++i) {
                  const int tt = ttb + (bt * 4 + i) * 8;
                  const int lt = tt0 + tt;
                  const int pos = lt & (G.L - 1);
                  const float xp = pos > 0 ? bf2f(rp[i]) : 0.f;
                  const float xn = pos < G.L - 1 ? bf2f(rn[i]) : 0.f;
                  const float x0 = w0 * xp + w1 * bf2f(rc[i]) + w2 * xn + wbb;
                  Y[(size_t)lt * 2048 + 1024 + c] = f2bf(x0 * lds[cc * 65 + tt] * siluf(bf2f(rz[i])));
                }
              }
            }
            __syncthreads();
          }
        }
      }
#endif
      GSYNC();
#ifndef NO_PH6
      {
        EpiResid e{p, layer, tok0};
        gemm_phase(Y, 2048, (even ? WT_EVOUT : WT_ODOUT) + (size_t)li * 1024 * 2048, 2048, 2048, GT, 1024, smem, e);
      }
#endif
      GSYNC();
#ifndef NO_CA
    {
      const int tid = opaque((int)threadIdx.x), lane = tid & 63, w = tid >> 6; (void)lane; (void)w;
      const float* gca = p.in[5] + layer * 1024;
      const int S = nblk * 8;
      for (int r = bid * 8 + w; r < GT; r += 4 * S) {
        float hn[4][16];
        norm_rows<4>([&](int k) { const int rr = r + k * S; return p.out + (size_t)(tok0 + (rr < GT ? rr : r)) * 1024; }, gca,
                     [&](int k) { const int rr = r + k * S; return HQ + (size_t)(rr < GT ? rr : r) * 1024; },
                     [&](int k) { return r + k * S < GT; }, hn, lane);
      }
    }
    GSYNC();
    {
      EpiPlain e{QC, 1024};
      gemm_phase(HQ, 1024, WT_Q + (size_t)layer * 1024 * 1024, 1024, 1024, GT, 1024, smem, e);
    }
    GSYNC();
    {
      const int tid = opaque((int)threadIdx.x), lane = tid & 63, w = tid >> 6; (void)lane; (void)w;
      float* Ss = (float*)smem;
      u16* Ps = (u16*)(smem + 66560);
      const u16* KMl = KM + (size_t)layer * 2304 * 1024;
      const u16* VTl = VTM + (size_t)layer * 2304 * 1024;
      for (int t = bid; t < (GT / 64) * 4; t += nblk) {
        const int tile = t >> 2, h = t & 3;
        const int tk0 = tile * 64;
        const int sq_ = seq_of_tok(tok0 + tk0);
        const int tid_o = tid;
        const int wm = w >> 2, wn = w & 3;
        {
          f32x16 acc[1][2];
          zero_acc<1, 2>(acc);
          wave_mma_g<1, 2, true>(acc, QC + (size_t)(tk0 + wm * 32) * 1024 + h * 256, 1024, KMl + (size_t)(sq_ * 256 + wn * 64) * 1024 + h * 256, 1024, 256);
#pragma unroll
          for (int ni = 0; ni < 2; ++ni)
#pragma unroll
            for (int r = 0; r < 16; ++r) {
              const int rr = wm * 32 + (r & 3) + 8 * (r >> 2) + 4 * (lane >> 5);
              Ss[rr * 260 + wn * 64 + ni * 32 + (lane & 31)] = acc[0][ni][r] * 0.0625f;
            }
        }
        __syncthreads();
        {
          const int row = tid_o >> 3, sub = tid_o & 7;
          float mx = -1e30f;
#pragma unroll
          for (int j = 0; j < 32; ++j) mx = fmaxf(mx, Ss[row * 260 + sub * 32 + j]);
          mx = fmaxf(mx, __shfl_xor(mx, 1)); mx = fmaxf(mx, __shfl_xor(mx, 2)); mx = fmaxf(mx, __shfl_xor(mx, 4));
          float ev[32];
          float sm = 0.f;
#pragma unroll
          for (int j = 0; j < 32; ++j) { ev[j] = __expf(Ss[row * 260 + sub * 32 + j] - mx); sm += ev[j]; }
          sm += __shfl_xor(sm, 1); sm += __shfl_xor(sm, 2); sm += __shfl_xor(sm, 4);
          const float inv = 1.f / sm;
#pragma unroll
          for (int q = 0; q < 4; ++q) {
            uint4 u;
            u.x = pack2(ev[q * 8] * inv, ev[q * 8 + 1] * inv); u.y = pack2(ev[q * 8 + 2] * inv, ev[q * 8 + 3] * inv);
            u.z = pack2(ev[q * 8 + 4] * inv, ev[q * 8 + 5] * inv); u.w = pack2(ev[q * 8 + 6] * inv, ev[q * 8 + 7] * inv);
            *(uint4*)(Ps + row * 264 + sub * 32 + q * 8) = u;
          }
        }
        __syncthreads();
        {
          f32x16 acc[1][2];
          zero_acc<1, 2>(acc);
          wave_mma_g<1, 2, false>(acc, Ps + wm * 32 * 264, 264, VTl + ((size_t)sq_ * 1024 + h * 256 + wn * 64) * 256, 256, 256);
          const int li4 = lane & 3;
#pragma unroll
          for (int ni = 0; ni < 2; ++ni)
#pragma unroll
            for (int q = 0; q < 4; ++q) {
              float v0 = acc[0][ni][4 * q], v1 = acc[0][ni][4 * q + 1], v2 = acc[0][ni][4 * q + 2], v3 = acc[0][ni][4 * q + 3];
              {
                const bool od = li4 & 1;
                const float r0 = __shfl_xor(od ? v0 : v1, 1), r1 = __shfl_xor(od ? v2 : v3, 1);
                if (od) { v0 = r0; v2 = r1; } else { v1 = r0; v3 = r1; }
              }
              {
                const bool hi = li4 & 2;
                const float r0 = __shfl_xor(hi ? v0 : v2, 2), r1 = __shfl_xor(hi ? v1 : v3, 2);
                if (hi) { v0 = r0; v1 = r1; } else { v2 = r0; v3 = r1; }
              }
              const int rr = wm * 32 + 8 * q + 4 * (lane >> 5) + li4;
              st4r(HQ + (size_t)(tk0 + rr) * 1024 + h * 256 + wn * 64 + ni * 32 + ((lane & 31) & ~3), v0, v1, v2, v3);
            }
        }
        __syncthreads();
      }
    }
    GSYNC();
    {
      EpiResid e{p, 1, tok0};
      gemm_phase(HQ, 1024, WT_O + (size_t)layer * 1024 * 1024, 1024, 1024, GT, 1024, smem, e);
    }
    GSYNC();
#endif
    }
  }
  {
    const int tid = opaque((int)threadIdx.x), lane = tid & 63, w = tid >> 6; (void)lane; (void)w;
    const float* gfin = p.in[7];
    const int S = nblk * 8;
    float4 gg[4];
#pragma unroll
    for (int i = 0; i < 4; ++i) gg[i] = *(const float4*)(gfin + i * 256 + lane * 4);
    for (int r = bid * 8 + w; r < TOK; r += 4 * S) {
      float4 v[4][4];
#pragma unroll
      for (int k = 0; k < 4; ++k) {
        const int rr = (r + k * S < TOK) ? r + k * S : r;
#pragma unroll
        for (int i = 0; i < 4; ++i) v[k][i] = *(const float4*)(p.out + (size_t)rr * 1024 + i * 256 + lane * 4);
      }
#pragma unroll
      for (int k = 0; k < 4; ++k) {
        float ss = 0.f;
#pragma unroll
        for (int i = 0; i < 4; ++i) ss += v[k][i].x * v[k][i].x + v[k][i].y * v[k][i].y + v[k][i].z * v[k][i].z + v[k][i].w * v[k][i].w;
        ss = wave_sum(ss);
        const float rr_ = rsqrtf(ss * (1.f / 1024.f) + 1e-6f);
        if (r + k * S < TOK) {
          float* x = p.out + (size_t)(r + k * S) * 1024;
#pragma unroll
          for (int i = 0; i < 4; ++i)
            *(float4*)(x + i * 256 + lane * 4) = make_float4(v[k][i].x * rr_ * gg[i].x, v[k][i].y * rr_ * gg[i].y, v[k][i].z * rr_ * gg[i].z, v[k][i].w * rr_ * gg[i].w);
        }
      }
    }
  }
}

extern "C" void kernel_launch(void* const* d_in, const int* in_sizes, int n_in, void* d_out, int out_size, void* d_ws,
                              size_t ws_size, hipStream_t stream) {
  static int grid_blocks = 0;
  if (!grid_blocks) {
    int dev = 0, cus = 0, per_cu = 0;
    hipGetDevice(&dev);
    hipDeviceGetAttribute(&cus, hipDeviceAttributeMultiprocessorCount, dev);
    hipOccupancyMaxActiveBlocksPerMultiprocessor(&per_cu, fwd_kernel, NTHR, 0);
    if (per_cu < 1) per_cu = 1;
    grid_blocks = cus * per_cu;
  }
  if (ws_size < WS_NEED) { fprintf(stderr, "workspace too small: %zu < %zu\n", ws_size, (size_t)WS_NEED); return; }
  Params p{};
  for (int i = 0; i < 32; ++i) p.in[i] = (const float*)d_in[i];
  p.out = (float*)d_out;
  p.ws = (char*)d_ws;
  hipMemsetAsync((char*)d_ws + OFF_BAR, 0, 16384, stream);
  void* args[] = {&p};
  hipError_t e = hipLaunchCooperativeKernel((void*)fwd_kernel, dim3(grid_blocks), dim3(NTHR), args, 0, stream);
  if (e != hipSuccess) fprintf(stderr, "cooperative launch failed: %s (grid %d)\n", hipGetErrorString(e), grid_blocks);
}
```

```cpp
#include <hip/hip_runtime.h>
#include <hip/hip_cooperative_groups.h>
#include <stdint.h>
#include <stdio.h>
namespace cg = cooperative_groups;
#define GSYNC() xcd_barrier(xb)

typedef unsigned short u16;
typedef __attribute__((ext_vector_type(8))) short bf16x8;
typedef __attribute__((ext_vector_type(16))) float f32x16;
typedef __attribute__((ext_vector_type(4))) unsigned u32x4;

#define NTHR 512
#define SMEM_BYTES 155648
constexpr int GT = 16384;
constexpr int TOK = 81920;

constexpr size_t SZ_WT_EVIN = 2ull * 9216 * 1024 * 2;
constexpr size_t SZ_WT_EVOUT = 2ull * 1024 * 2048 * 2;
constexpr size_t SZ_WT_ODIN = 2ull * 6144 * 1024 * 2;
constexpr size_t SZ_WT_ODOUT = 2ull * 1024 * 2048 * 2;
constexpr size_t SZ_WT_Q = 4ull * 1024 * 1024 * 2;
constexpr size_t SZ_WT_KV = 4ull * 2048 * 1024 * 2;
constexpr size_t SZ_WT_O = 4ull * 1024 * 1024 * 2;
constexpr size_t SZ_KM = 4ull * 2304 * 1024 * 2;
constexpr size_t SZ_ROPE = 16384ull * 128 * 8;
constexpr size_t SZ_TW = 16384ull * 8;
constexpr size_t SZ_G = 16384ull * 16 * 4;
constexpr size_t SZ_NV = 128ull * 4 * 2 * 256 * 4;
constexpr size_t SZ_CS = 128ull * 4 * 4 * 4;
constexpr size_t SZ_MS = 128ull * 4 * 2 * 4;

constexpr size_t OFF_WT_EVIN = 0;
constexpr size_t OFF_WT_EVOUT = OFF_WT_EVIN + SZ_WT_EVIN;
constexpr size_t OFF_WT_ODIN = OFF_WT_EVOUT + SZ_WT_EVOUT;
constexpr size_t OFF_WT_ODOUT = OFF_WT_ODIN + SZ_WT_ODIN;
constexpr size_t OFF_WT_Q = OFF_WT_ODOUT + SZ_WT_ODOUT;
constexpr size_t OFF_WT_KV = OFF_WT_Q + SZ_WT_Q;
constexpr size_t OFF_WT_O = OFF_WT_KV + SZ_WT_KV;
constexpr size_t OFF_KM = OFF_WT_O + SZ_WT_O;
constexpr size_t OFF_VTM = OFF_KM + SZ_KM;
constexpr size_t OFF_ROPE = OFF_VTM + SZ_KM;
constexpr size_t OFF_TW = OFF_ROPE + SZ_ROPE;
constexpr size_t OFF_G = OFF_TW + SZ_TW;
constexpr size_t OFF_NV = OFF_G + SZ_G;
constexpr size_t OFF_CS = OFF_NV + SZ_NV;
constexpr size_t OFF_MS = OFF_CS + SZ_CS;
constexpr size_t OFF_W3T = OFF_MS + SZ_MS;
constexpr size_t OFF_R = OFF_W3T + 2ull * 2048 * 64 * 2;
constexpr size_t R_P = OFF_R;
constexpr size_t R_VT = R_P + 16384ull * 6144 * 2;
constexpr size_t R_X1T = R_VT + 1024ull * 16384 * 2;
constexpr size_t R_VHT = R_X1T + 1024ull * 16384 * 2;
constexpr size_t R_QP = R_VHT + 1024ull * 16384 * 2;
constexpr size_t R_KP = R_QP + 1024ull * 16384 * 2;
constexpr size_t R_Y = R_KP + 1024ull * 16384 * 2;
constexpr size_t R_ST = R_Y + 16384ull * 2048 * 2;
constexpr size_t R_CT = R_ST + 1024ull * 65536 * 2;
constexpr size_t R_HK = R_CT + 1024ull * 16384 * 4;
constexpr size_t OFF_BAR = R_HK + 1024ull * 32768 * 4;
constexpr size_t WS_NEED = OFF_BAR + 16384;

struct Params {
  const float* in[32];
  float* out;
  char* ws;
};

__device__ __forceinline__ u16 f2bf(float f) { unsigned u = __float_as_uint(f); u += 0x7fffu + ((u >> 16) & 1u); return (u16)(u >> 16); }
__device__ __forceinline__ float bf2f(u16 h) { return __uint_as_float(((unsigned)h) << 16); }
__device__ __forceinline__ unsigned pack2(float a, float b) { return (unsigned)f2bf(a) | ((unsigned)f2bf(b) << 16); }
__device__ __forceinline__ float siluf(float x) { return x / (1.f + __expf(-x)); }
__device__ __forceinline__ float sigmf(float x) { return 1.f / (1.f + __expf(-x)); }
__device__ __forceinline__ float logsig(float x) { return fminf(x, 0.f) - log1pf(__expf(-fabsf(x))); }
__device__ __forceinline__ int opaque(int x) { asm volatile("" : "+v"(x)); return x; }
__device__ __forceinline__ float wave_sum(float v) {
#pragma unroll
  for (int o = 32; o; o >>= 1) v += __shfl_xor(v, o);
  return v;
}
__device__ __forceinline__ void unpack8(const uint4& v, float (&f)[8]) {
  f[0] = __uint_as_float(v.x << 16); f[1] = __uint_as_float(v.x & 0xffff0000u);
  f[2] = __uint_as_float(v.y << 16); f[3] = __uint_as_float(v.y & 0xffff0000u);
  f[4] = __uint_as_float(v.z << 16); f[5] = __uint_as_float(v.z & 0xffff0000u);
  f[6] = __uint_as_float(v.w << 16); f[7] = __uint_as_float(v.w & 0xffff0000u);
}
__device__ __forceinline__ uint4 pack8(const float (&f)[8]) {
  uint4 v; v.x = pack2(f[0], f[1]); v.y = pack2(f[2], f[3]); v.z = pack2(f[4], f[5]); v.w = pack2(f[6], f[7]); return v;
}
__device__ __forceinline__ const float* xrow_in(const Params& p, int layer, int tok) {
  if (layer == 0) return (tok < 16384) ? (p.in[0] + (size_t)tok * 1024) : (p.in[1] + (size_t)(tok - 16384) * 1024);
  return p.out + (size_t)tok * 1024;
}
__device__ __forceinline__ int seq_of_tok(int tok) { return tok < 16384 ? 0 : 1 + ((tok - 16384) >> 13); }

__device__ __forceinline__ void gload4(bf16x8& f0, bf16x8& f1, bf16x8& f2, bf16x8& f3, const u16* p) {
  asm volatile("global_load_dwordx4 %0, %4, off\n\tglobal_load_dwordx4 %1, %4, off offset:16\n\t"
               "global_load_dwordx4 %2, %4, off offset:32\n\tglobal_load_dwordx4 %3, %4, off offset:48"
               : "=&v"(f0), "=&v"(f1), "=&v"(f2), "=&v"(f3) : "v"(p) : "memory");
}
__device__ __forceinline__ void vmwait0() { asm volatile("s_waitcnt vmcnt(0)" ::: "memory"); }
__device__ __forceinline__ void touch(bf16x8& f) { asm volatile("" : "+v"(f)); }
__device__ __forceinline__ void gload2(bf16x8& f0, bf16x8& f1, const u16* p) {
  asm volatile("global_load_dwordx4 %0, %2, off\n\tglobal_load_dwordx4 %1, %2, off offset:16"
               : "=&v"(f0), "=&v"(f1) : "v"(p) : "memory");
}
template <int MT, int NT_, bool AG>
__device__ __forceinline__ void wave_mma_g(f32x16 (&acc)[MT][NT_], const u16* A, int lda, const u16* B, int ldb, int K) {
  constexpr int J = (MT >= 4) ? 2 : 4;
  constexpr int KB = 16 * J;
  const int lane = opaque((int)threadIdx.x) & 63;
  const u16* ap = A + (size_t)(lane & 31) * lda + (lane >> 5) * (8 * J);
  const u16* bp = B + (size_t)(lane & 31) * ldb + (lane >> 5) * (8 * J);
#pragma unroll 1
  for (int kb = 0; kb < K; kb += KB) {
    bf16x8 a[MT][J], b[NT_][J];
#pragma unroll
    for (int ni = 0; ni < NT_; ++ni) {
      if (J == 4) gload4(b[ni][0], b[ni][1], b[ni][J - 2], b[ni][J - 1], bp + (size_t)ni * 32 * ldb + kb);
      else gload2(b[ni][0], b[ni][1], bp + (size_t)ni * 32 * ldb + kb);
    }
    if (AG) {
#pragma unroll
      for (int mi = 0; mi < MT; ++mi) {
        if (J == 4) gload4(a[mi][0], a[mi][1], a[mi][J - 2], a[mi][J - 1], ap + (size_t)mi * 32 * lda + kb);
        else gload2(a[mi][0], a[mi][1], ap + (size_t)mi * 32 * lda + kb);
      }
    } else {
#pragma unroll
      for (int mi = 0; mi < MT; ++mi)
#pragma unroll
        for (int j = 0; j < J; ++j) a[mi][j] = *(const bf16x8*)(ap + (size_t)mi * 32 * lda + kb + j * 8);
    }
    vmwait0();
#pragma unroll
    for (int ni = 0; ni < NT_; ++ni)
#pragma unroll
      for (int j = 0; j < J; ++j) touch(b[ni][j]);
    if (AG) {
#pragma unroll
      for (int mi = 0; mi < MT; ++mi)
#pragma unroll
        for (int j = 0; j < J; ++j) touch(a[mi][j]);
    }
#pragma unroll
    for (int j = 0; j < J; ++j)
#pragma unroll
      for (int mi = 0; mi < MT; ++mi)
#pragma unroll
        for (int ni = 0; ni < NT_; ++ni)
          acc[mi][ni] = __builtin_amdgcn_mfma_f32_32x32x16_bf16(a[mi][j], b[ni][j], acc[mi][ni], 0, 0, 0);
  }
}
template <int MT, int NT_>
__device__ __forceinline__ void zero_acc(f32x16 (&acc)[MT][NT_]) {
#pragma unroll
  for (int mi = 0; mi < MT; ++mi)
#pragma unroll
    for (int ni = 0; ni < NT_; ++ni)
#pragma unroll
      for (int r = 0; r < 16; ++r) acc[mi][ni][r] = 0.f;
}

#ifndef GEMM_NI
#define GEMM_NI 4
#endif
template <int NI, class E>
__device__ __forceinline__ void gemm_stream(const u16* __restrict__ A, int lda, const u16* __restrict__ BT, int ldb, int K, int M, int N,
                                            char* smem, const E& epi) {
  constexpr int BN = 64 * NI;
  constexpr int NBL = NI;
  u16* As = (u16*)smem;
  u16* Bs = As + 2 * 256 * 72;
  const int tid = opaque((int)threadIdx.x), lane = tid & 63, w = tid >> 6, wm = w >> 1, wn = w & 1;
  const int ntm = M >> 8, ntn = N / BN, ntiles = ntm * ntn;
  int t = blockIdx.x;
  if (t >= ntiles) return;
  const int nk = K >> 6;
  const int lr = tid >> 3, lc = (tid & 7) * 8;
  int tn = t / ntm, tm = t - tn * ntm;
  unsigned aoff = (unsigned)(tm * 256 + lr) * (unsigned)lda + lc;
  unsigned boff = (unsigned)(tn * BN + lr) * (unsigned)ldb + lc;
  {
    uint4 pa[4], pb[NBL];
#pragma unroll
    for (int i = 0; i < 4; ++i) pa[i] = *(const uint4*)(A + aoff + (unsigned)(64 * i) * lda);
#pragma unroll
    for (int i = 0; i < NBL; ++i) pb[i] = *(const uint4*)(BT + boff + (unsigned)(64 * i) * ldb);
#pragma unroll
    for (int i = 0; i < 4; ++i) *(uint4*)(As + (lr + 64 * i) * 72 + lc) = pa[i];
#pragma unroll
    for (int i = 0; i < NBL; ++i) *(uint4*)(Bs + (lr + 64 * i) * 72 + lc) = pb[i];
  }
  __syncthreads();
  int cur = 0;
  while (true) {
    f32x16 acc[2][NI];
    zero_acc<2, NI>(acc);
    const int tnext = t + gridDim.x;
    int tn2 = tn, tm2 = tm;
    if (tnext < ntiles) { tn2 = tnext / ntm; tm2 = tnext - tn2 * ntm; }
    const unsigned aoff2 = (unsigned)(tm2 * 256 + lr) * (unsigned)lda + lc;
    const unsigned boff2 = (unsigned)(tn2 * BN + lr) * (unsigned)ldb + lc;
    for (int kt = 0; kt < nk; ++kt) {
      const bool last = (kt + 1 == nk);
      const unsigned an = last ? aoff2 : aoff + (kt + 1) * 64;
      const unsigned bn = last ? boff2 : boff + (kt + 1) * 64;
      u32x4 ra[4], rb[NBL];
#pragma unroll
      for (int i = 0; i < 4; ++i) {
        const u16* gp = A + an + (unsigned)(64 * i) * lda;
        asm volatile("global_load_dwordx4 %0, %1, off" : "=&v"(ra[i]) : "v"(gp) : "memory");
      }
#pragma unroll
      for (int i = 0; i < NBL; ++i) {
        const u16* gp = BT + bn + (unsigned)(64 * i) * ldb;
        asm volatile("global_load_dwordx4 %0, %1, off" : "=&v"(rb[i]) : "v"(gp) : "memory");
      }
      const u16* as = As + cur * 256 * 72 + (wm * 64 + (lane & 31)) * 72 + (lane >> 5) * 8;
      const u16* bs = Bs + cur * BN * 72 + (wn * 32 * NI + (lane & 31)) * 72 + (lane >> 5) * 8;
#pragma unroll
      for (int ks = 0; ks < 4; ++ks) {
        bf16x8 a[2], b[NI];
#pragma unroll
        for (int mi = 0; mi < 2; ++mi) a[mi] = *(const bf16x8*)(as + mi * 32 * 72 + ks * 16);
#pragma unroll
        for (int ni = 0; ni < NI; ++ni) b[ni] = *(const bf16x8*)(bs + ni * 32 * 72 + ks * 16);
#pragma unroll
        for (int mi = 0; mi < 2; ++mi)
#pragma unroll
          for (int ni = 0; ni < NI; ++ni)
            acc[mi][ni] = __builtin_amdgcn_mfma_f32_32x32x16_bf16(a[mi], b[ni], acc[mi][ni], 0, 0, 0);
      }
      asm volatile("s_waitcnt vmcnt(0)" ::: "memory");
#pragma unroll
      for (int i = 0; i < 4; ++i) asm volatile("" : "+v"(ra[i]));
#pragma unroll
      for (int i = 0; i < NBL; ++i) asm volatile("" : "+v"(rb[i]));
      {
        const int nx = cur ^ 1;
#pragma unroll
        for (int i = 0; i < 4; ++i) *(u32x4*)(As + nx * 256 * 72 + (lr + 64 * i) * 72 + lc) = ra[i];
#pragma unroll
        for (int i = 0; i < NBL; ++i) *(u32x4*)(Bs + nx * BN * 72 + (lr + 64 * i) * 72 + lc) = rb[i];
      }
      __syncthreads();
      cur ^= 1;
    }
    {
      const int lane_e = opaque(lane);
      const int row0 = tm * 256, col0 = tn * BN;
      const int li4 = lane_e & 3;
#pragma unroll
      for (int ni = 0; ni < NI; ++ni) {
        const int colb = col0 + wn * 32 * NI + ni * 32;
        if (epi.transposed(colb)) {
          const int hh_e = lane_e >> 5;
#pragma unroll
          for (int mi = 0; mi < 2; ++mi)
#pragma unroll
            for (int pq = 0; pq < 2; ++pq) {
              const unsigned e0 = pack2(acc[mi][ni][8 * pq], acc[mi][ni][8 * pq + 1]), e1 = pack2(acc[mi][ni][8 * pq + 2], acc[mi][ni][8 * pq + 3]);
              const unsigned o0 = pack2(acc[mi][ni][8 * pq + 4], acc[mi][ni][8 * pq + 5]), o1 = pack2(acc[mi][ni][8 * pq + 6], acc[mi][ni][8 * pq + 7]);
              const unsigned s0 = hh_e ? e0 : o0, s1 = hh_e ? e1 : o1;
              const unsigned r0 = (unsigned)__shfl_xor((int)s0, 32), r1 = (unsigned)__shfl_xor((int)s1, 32);
              uint4 u;
              if (hh_e) { u.x = r0; u.y = r1; u.z = o0; u.w = o1; } else { u.x = e0; u.y = e1; u.z = r0; u.w = r1; }
              const int row = row0 + wm * 64 + mi * 32 + 16 * pq + 8 * hh_e;
              epi.t8(row, colb + (lane_e & 31), u);
            }
        } else {
#pragma unroll
          for (int mi = 0; mi < 2; ++mi)
#pragma unroll
            for (int q = 0; q < 4; ++q) {
              float v0 = acc[mi][ni][4 * q], v1 = acc[mi][ni][4 * q + 1], v2 = acc[mi][ni][4 * q + 2], v3 = acc[mi][ni][4 * q + 3];
              {
                const bool od = li4 & 1;
                const float r0 = __shfl_xor(od ? v0 : v1, 1), r1 = __shfl_xor(od ? v2 : v3, 1);
                if (od) { v0 = r0; v2 = r1; } else { v1 = r0; v3 = r1; }
              }
              {
                const bool hi = li4 & 2;
                const float r0 = __shfl_xor(hi ? v0 : v2, 2), r1 = __shfl_xor(hi ? v1 : v3, 2);
                if (hi) { v0 = r0; v1 = r1; } else { v2 = r0; v3 = r1; }
              }
              const int row = row0 + wm * 64 + mi * 32 + 8 * q + 4 * (lane_e >> 5) + li4;
              epi.r(row, colb + ((lane_e & 31) & ~3), v0, v1, v2, v3);
            }
        }
      }
    }
    if (tnext >= ntiles) break;
    t = tnext; tn = tn2; tm = tm2; aoff = aoff2; boff = boff2;
  }
}

template <class E>
__device__ __forceinline__ void gemm_phase(const u16* A, int lda, const u16* BT, int ldb, int K, int M, int N, char* smem, const E& epi) {
  gemm_stream<GEMM_NI>(A, lda, BT, ldb, K, M, N, smem, epi);
  __syncthreads();
}

__device__ __forceinline__ void st4(u16* p, int ld, float v0, float v1, float v2, float v3) {
  p[0] = f2bf(v0); p[ld] = f2bf(v1); p[2 * ld] = f2bf(v2); p[3 * ld] = f2bf(v3);
}
__device__ __forceinline__ void st4t(u16* p, float v0, float v1, float v2, float v3) {
  uint2 u; u.x = pack2(v0, v1); u.y = pack2(v2, v3); *(uint2*)p = u;
}

__device__ __forceinline__ void st4r(u16* p, float v0, float v1, float v2, float v3) {
  uint2 u; u.x = pack2(v0, v1); u.y = pack2(v2, v3); *(uint2*)p = u;
}
struct EpiEvenIn {
  u16 *P, *VT, *X1T, *VHT;
  __device__ __forceinline__ bool transposed(int colb) const { const int seg = colb >> 10; return seg == 2 || seg == 6 || seg == 7; }
  __device__ __forceinline__ void t(int row, int col, float v0, float v1, float v2, float v3) const {
    const int seg = col >> 10, c = col & 1023;
    const int idx = (seg == 2) ? 0 : (seg - 5);
    st4t(VT + (size_t)idx * 1024 * GT + (size_t)c * GT + row, v0, v1, v2, v3);
  }
  __device__ __forceinline__ void t8(int row, int col, const uint4& u) const {
    const int seg = col >> 10, c = col & 1023;
    const int idx = (seg == 2) ? 0 : (seg - 5);
    *(uint4*)(VT + (size_t)idx * 1024 * GT + (size_t)c * GT + row) = u;
  }
  __device__ __forceinline__ void r(int row, int col, float v0, float v1, float v2, float v3) const {
    const int seg = col >> 10;
    const int pc = (seg < 2) ? col : (seg < 6 ? col - 1024 : col - 3072);
    st4r(P + (size_t)row * 6144 + pc, v0, v1, v2, v3);
  }
};
struct EpiOddIn {
  u16 *P, *VT;
  __device__ __forceinline__ bool transposed(int colb) const { const int seg = colb >> 10; return seg == 2 || seg == 3; }
  __device__ __forceinline__ void t(int row, int col, float v0, float v1, float v2, float v3) const {
    st4t(VT + (size_t)(col - 2048) * GT + row, v0, v1, v2, v3);
  }
  __device__ __forceinline__ void t8(int row, int col, const uint4& u) const { *(uint4*)(VT + (size_t)(col - 2048) * GT + row) = u; }
  __device__ __forceinline__ void r(int row, int col, float v0, float v1, float v2, float v3) const {
    const int pc = (col < 2048) ? col : col - 2048;
    st4r(P + (size_t)row * 4096 + pc, v0, v1, v2, v3);
  }
};
struct EpiResid {
  Params p; int layer; int tokbase;
  __device__ __forceinline__ bool transposed(int) const { return false; }
  __device__ __forceinline__ void t(int, int, float, float, float, float) const {}
  __device__ __forceinline__ void t8(int, int, const uint4&) const {}
  __device__ __forceinline__ void r(int row, int col, float v0, float v1, float v2, float v3) const {
    const int tok = tokbase + row;
    const float* xb = xrow_in(p, layer, tokbase);
    const float4 x = *(const float4*)(xb + (size_t)row * 1024 + col);
    *(float4*)(p.out + (size_t)tok * 1024 + col) = make_float4(x.x + v0, x.y + v1, x.z + v2, x.w + v3);
  }
};
struct EpiPlain {
  u16* C; int ldc;
  __device__ __forceinline__ bool transposed(int) const { return false; }
  __device__ __forceinline__ void t(int, int, float, float, float, float) const {}
  __device__ __forceinline__ void t8(int, int, const uint4&) const {}
  __device__ __forceinline__ void r(int row, int col, float v0, float v1, float v2, float v3) const {
    st4r(C + (size_t)row * ldc + col, v0, v1, v2, v3);
  }
};
struct EpiKV {
  u16 *KM, *VTM;
  __device__ __forceinline__ bool transposed(int colb) const { return colb >= 1024; }
  __device__ __forceinline__ void t(int row, int col, float v0, float v1, float v2, float v3) const {
    st4t(VTM + ((size_t)(row >> 8) * 1024 + (col - 1024)) * 256 + (row & 255), v0, v1, v2, v3);
  }
  __device__ __forceinline__ void t8(int row, int col, const uint4& u) const {
    *(uint4*)(VTM + ((size_t)(row >> 8) * 1024 + (col - 1024)) * 256 + (row & 255)) = u;
  }
  __device__ __forceinline__ void r(int row, int col, float v0, float v1, float v2, float v3) const {
    st4r(KM + (size_t)row * 1024 + col, v0, v1, v2, v3);
  }
};

__device__ void tc_matrix(const float* __restrict__ src, int ld, int col0, int K, int N, u16* __restrict__ dst, char* smem) {
  float* lds = (float*)smem;
  const int tid = threadIdx.x;
  const int tn = N >> 6, tk = K >> 6;
  for (int t = blockIdx.x; t < tn * tk; t += gridDim.x) {
    const int k0 = (t / tn) << 6, n0 = (t % tn) << 6;
    float tv[8];
#pragma unroll
    for (int i = 0; i < 8; ++i) {
      const int e = tid + i * 512, kk = e >> 6, nn = e & 63;
      tv[i] = src[(size_t)(k0 + kk) * ld + col0 + n0 + nn];
    }
    asm volatile("" ::: "memory");
#pragma unroll
    for (int i = 0; i < 8; ++i) {
      const int e = tid + i * 512, kk = e >> 6, nn = e & 63;
      lds[kk * 65 + nn] = tv[i];
    }
    __syncthreads();
    const int n = tid >> 3, kq = tid & 7;
    float f[8];
#pragma unroll
    for (int j = 0; j < 8; ++j) f[j] = lds[(kq * 8 + j) * 65 + n];
    *(uint4*)(dst + (size_t)(n0 + n) * K + k0 + kq * 8) = pack8(f);
    __syncthreads();
  }
}

__device__ __forceinline__ void norm_row(const float* __restrict__ x, const float* __restrict__ g, u16* __restrict__ o, float (&hn)[16], const int lane) {
  float4 v[4];
  float ss = 0.f;
#pragma unroll
  for (int i = 0; i < 4; ++i) {
    v[i] = *(const float4*)(x + i * 256 + lane * 4);
    ss += v[i].x * v[i].x + v[i].y * v[i].y + v[i].z * v[i].z + v[i].w * v[i].w;
  }
  ss = wave_sum(ss);
  const float r = rsqrtf(ss * (1.f / 1024.f) + 1e-6f);
#pragma unroll
  for (int i = 0; i < 4; ++i) {
    const float4 gg = *(const float4*)(g + i * 256 + lane * 4);
    hn[i * 4 + 0] = v[i].x * r * gg.x; hn[i * 4 + 1] = v[i].y * r * gg.y;
    hn[i * 4 + 2] = v[i].z * r * gg.z; hn[i * 4 + 3] = v[i].w * r * gg.w;
    uint2 u; u.x = pack2(hn[i * 4], hn[i * 4 + 1]); u.y = pack2(hn[i * 4 + 2], hn[i * 4 + 3]);
    *(uint2*)(o + i * 256 + lane * 4) = u;
  }
}

template <int R, class XF, class OF, class KF>
__device__ __forceinline__ void norm_rows(XF xf, const float* __restrict__ g, OF of, KF okf, float (&hn)[R][16], const int lane) {
  float4 v[R][4];
#pragma unroll
  for (int r = 0; r < R; ++r) {
    const float* x = xf(r);
#pragma unroll
    for (int i = 0; i < 4; ++i) v[r][i] = *(const float4*)(x + i * 256 + lane * 4);
  }
  float4 gg[4];
#pragma unroll
  for (int i = 0; i < 4; ++i) gg[i] = *(const float4*)(g + i * 256 + lane * 4);
#pragma unroll
  for (int r = 0; r < R; ++r) {
    float ss = 0.f;
#pragma unroll
    for (int i = 0; i < 4; ++i) ss += v[r][i].x * v[r][i].x + v[r][i].y * v[r][i].y + v[r][i].z * v[r][i].z + v[r][i].w * v[r][i].w;
    ss = wave_sum(ss);
    const float rs = rsqrtf(ss * (1.f / 1024.f) + 1e-6f);
    u16* o = of(r);
    const bool ok = okf(r);
#pragma unroll
    for (int i = 0; i < 4; ++i) {
      hn[r][i * 4 + 0] = v[r][i].x * rs * gg[i].x; hn[r][i * 4 + 1] = v[r][i].y * rs * gg[i].y;
      hn[r][i * 4 + 2] = v[r][i].z * rs * gg[i].z; hn[r][i * 4 + 3] = v[r][i].w * rs * gg[i].w;
      uint2 u; u.x = pack2(hn[r][i * 4], hn[r][i * 4 + 1]); u.y = pack2(hn[r][i * 4 + 2], hn[r][i * 4 + 3]);
      if (ok) *(uint2*)(o + i * 256 + lane * 4) = u;
    }
  }
}

__device__ __forceinline__ float2 cmul(float2 a, float2 b) { return make_float2(a.x * b.x - a.y * b.y, a.x * b.y + a.y * b.x); }
__device__ __forceinline__ float2 twid(float x) {
  return make_float2(__builtin_amdgcn_cosf(x), -__builtin_amdgcn_sinf(x));
}
__device__ __forceinline__ float2 cadd(float2 a, float2 b) { return make_float2(a.x + b.x, a.y + b.y); }
__device__ __forceinline__ float2 csub(float2 a, float2 b) { return make_float2(a.x - b.x, a.y - b.y); }
__device__ void fft_fwd(float2* buf, int logM) {
  const int nq = 1 << (logM - 2);
  int s = logM - 1;
  for (; s >= 1; s -= 2) {
    const int q = 1 << (s - 1);
    const float invn = 1.f / (float)(4 * q);
    for (int t = threadIdx.x; t < nq; t += NTHR) {
      const int j = t & (q - 1), i0 = ((t >> (s - 1)) << (s + 1)) + j;
      const float2 a0 = buf[i0], a1 = buf[i0 + q], a2 = buf[i0 + 2 * q], a3 = buf[i0 + 3 * q];
      const float2 w1 = twid((float)j * invn);
      const float2 w1p = make_float2(w1.y, -w1.x);
      const float2 w2 = cmul(w1, w1);
      const float2 c0 = cadd(a0, a2), c2 = cmul(csub(a0, a2), w1);
      const float2 c1 = cadd(a1, a3), c3 = cmul(csub(a1, a3), w1p);
      buf[i0] = cadd(c0, c1);
      buf[i0 + q] = cmul(csub(c0, c1), w2);
      buf[i0 + 2 * q] = cadd(c2, c3);
      buf[i0 + 3 * q] = cmul(csub(c2, c3), w2);
    }
    __syncthreads();
  }
  if (s == 0) {
    for (int t = threadIdx.x; t < (1 << (logM - 1)); t += NTHR) {
      const float2 u = buf[2 * t], v = buf[2 * t + 1];
      buf[2 * t] = cadd(u, v);
      buf[2 * t + 1] = csub(u, v);
    }
    __syncthreads();
  }
}
__device__ void fft_inv(float2* buf, int logM) {
  const int nq = 1 << (logM - 2);
  int s = 0;
  if (logM & 1) {
    for (int t = threadIdx.x; t < (1 << (logM - 1)); t += NTHR) {
      const float2 u = buf[2 * t], v = buf[2 * t + 1];
      buf[2 * t] = cadd(u, v);
      buf[2 * t + 1] = csub(u, v);
    }
    __syncthreads();
    s = 1;
  }
  for (; s < logM; s += 2) {
    const int q = 1 << s;
    const float invn = 1.f / (float)(4 * q);
    for (int t = threadIdx.x; t < nq; t += NTHR) {
      const int j = t & (q - 1), i0 = ((t >> s) << (s + 2)) + j;
      const float2 x0 = buf[i0], x1 = buf[i0 + q], x2 = buf[i0 + 2 * q], x3 = buf[i0 + 3 * q];
      float2 w1 = twid((float)j * invn); w1.y = -w1.y;
      const float2 w2 = cmul(w1, w1);
      const float2 w1p = make_float2(-w1.y, w1.x);
      const float2 t1 = cmul(x1, w2), t3 = cmul(x3, w2);
      const float2 y0 = cadd(x0, t1), y1 = csub(x0, t1), y2 = cadd(x2, t3), y3 = csub(x2, t3);
      const float2 u2 = cmul(y2, w1), u3 = cmul(y3, w1p);
      buf[i0] = cadd(y0, u2);
      buf[i0 + 2 * q] = csub(y0, u2);
      buf[i0 + q] = cadd(y1, u3);
      buf[i0 + 3 * q] = csub(y1, u3);
    }
    __syncthreads();
  }
}
__device__ __forceinline__ int brev(int k, int logM) { return (int)(__brev((unsigned)k) >> (32 - logM)); }

struct Grp { int g, nb, L, ncs, logL; };
__device__ __forceinline__ Grp mk_grp(int g) {
  Grp r; r.g = g; r.nb = g == 0 ? 1 : 2; r.L = GT / r.nb; r.ncs = r.L >> 7; r.logL = g == 0 ? 14 : 13; return r;
}

__device__ void chunk_gates(const float* __restrict__ G, const float* __restrict__ bias, int lt0, int h, float* sg) {
  const int tid = threadIdx.x, lane = tid & 63, w = tid >> 6;
  float pf = 0.f, sb = 0.f;
  if (tid < 128) {
    const float* gr = G + (size_t)(lt0 + tid) * 16;
    sg[256 + tid] = gr[h] + bias[h];
    pf = logsig(gr[4 + h] + bias[4 + h]);
    sg[384 + tid] = gr[8 + h] + bias[8 + h];
    sb = logsig(gr[12 + h] + bias[12 + h]);
#pragma unroll
    for (int o = 1; o < 64; o <<= 1) {
      const float t1 = __shfl_up(pf, o), t2 = __shfl_down(sb, o);
      if (lane >= o) pf += t1;
      if (lane + o < 64) sb += t2;
    }
    if (lane == 63) sg[512 + w] = pf;
    if (lane == 0) sg[514 + w] = sb;
  }
  __syncthreads();
  if (tid < 128) {
    if (w == 1) pf += sg[512];
    if (w == 0) sb += sg[515];
    sg[tid] = pf; sg[128 + tid] = sb;
  }
  __syncthreads();
}

#define XB_TMO      128
#define XB_XCNT(j)  (256  + 64 * (j))
#define XB_XSUB(j)  (1280 + 64 * (j))
#define XB_XGEN(j)  (2304 + 64 * (j))
#define XB_TOP      3328
#define XB_TOPGEN   3392
#define XCD_BAR_WORDS 3456
#define XB_SPIN_CAP (1u << 18)
#define LAS __attribute__((address_space(3)))

__device__ __forceinline__ unsigned xb_ld(unsigned* p)              { return __hip_atomic_load(p, __ATOMIC_RELAXED, __HIP_MEMORY_SCOPE_AGENT); }
__device__ __forceinline__ unsigned xb_add(unsigned* p, unsigned v) { return __hip_atomic_fetch_add(p, v, __ATOMIC_RELAXED, __HIP_MEMORY_SCOPE_AGENT); }
__device__ __forceinline__ unsigned xb_xcc_id() { return (unsigned)__builtin_amdgcn_s_getreg((3 << 11) | 20) & 0xFu; }
#define XB_SPIN(cond, bar) do { unsigned _sp = 0; while (cond) { __builtin_amdgcn_s_sleep(1); \
    if ((++_sp & 255u) == 0u) { if (xb_ld(&(bar)[XB_TMO])) break; if (_sp > XB_SPIN_CAP) { atomicAdd(&(bar)[XB_TMO], 1u); break; } } } } while (0)

struct XcdBarrier {
    unsigned* bar; unsigned x;
    volatile LAS unsigned* st;
};

__device__ __forceinline__ XcdBarrier xcd_barrier_post(unsigned* bar, volatile LAS unsigned* st) {
    XcdBarrier b; b.bar = bar; b.x = xb_xcc_id(); b.st = st;
    if (threadIdx.x == 0) (void)xb_add(&bar[XB_XCNT(b.x)], 1u);
    return b;
}
__device__ __forceinline__ void xcd_barrier_complete(unsigned* bar, unsigned x, unsigned& nloc, unsigned& nx) {
    const unsigned G = gridDim.x * gridDim.y * gridDim.z;
    unsigned sum, cnt, mine, sp = 0u;
    for (;;) {
        sum = 0u; cnt = 0u; mine = 0u;
#pragma unroll
        for (unsigned j = 0; j < 16; ++j) { const unsigned c = xb_ld(&bar[XB_XCNT(j)]); sum += c; cnt += (c > 0u) ? 1u : 0u; mine = (j == x) ? c : mine; }
        if (sum == G) break;
        __builtin_amdgcn_s_sleep(1);
        if ((++sp & 255u) == 0u) { if (xb_ld(&bar[XB_TMO])) break; if (sp > XB_SPIN_CAP) { atomicAdd(&bar[XB_TMO], 1u); break; } }
    }
    nloc = mine > 0u ? mine : 1u; nx = cnt > 0u ? cnt : 1u;
}

__device__ __attribute__((noinline)) void xcd_barrier(const XcdBarrier b) {
    asm volatile("s_waitcnt vmcnt(0)" ::: "memory");
    __syncthreads();
    if (threadIdx.x == 0) {
        unsigned* bar = b.bar;
        __builtin_amdgcn_s_waitcnt(0);
        unsigned nloc = b.st[0], nx = b.st[1];
        if (nloc == 0u) { xcd_barrier_complete(bar, b.x, nloc, nx); b.st[0] = nloc; b.st[1] = nx; }
        const unsigned old = xb_add(&bar[XB_XSUB(b.x)], 1u);
        const unsigned gen = old / nloc;
        if (old + 1u == (gen + 1u) * nloc) {
            __builtin_amdgcn_fence(__ATOMIC_RELEASE, "agent");
            asm volatile("s_waitcnt vmcnt(0)" ::: "memory");
            const unsigned og = xb_add(&bar[XB_TOP], 1u);
            const unsigned tg = og / nx;
            if (og + 1u == (tg + 1u) * nx) xb_add(&bar[XB_TOPGEN], 1u);
            else XB_SPIN(xb_ld(&bar[XB_TOPGEN]) == tg, bar);
            __builtin_amdgcn_fence(__ATOMIC_ACQUIRE, "agent");
            xb_add(&bar[XB_XGEN(b.x)], 1u);
            asm volatile("s_waitcnt vmcnt(0)" ::: "memory");
        } else {
            XB_SPIN(xb_ld(&bar[XB_XGEN(b.x)]) == gen, bar);
            __builtin_amdgcn_fence(__ATOMIC_ACQUIRE, "agent");
            asm volatile("s_waitcnt vmcnt(0)" ::: "memory");
        }
    }
    __syncthreads();
}


__global__ void __launch_bounds__(NTHR) fwd_kernel(Params p) {
  __shared__ __attribute__((aligned(16))) char smem[SMEM_BYTES];
  cg::grid_group grid = cg::this_grid();
  __shared__ uint4 xb_words;
  if (threadIdx.x == 0) xb_words = make_uint4(0u, 0u, 0u, 0u);
  __syncthreads();
  XcdBarrier xb = xcd_barrier_post((unsigned*)(p.ws + OFF_BAR), (volatile LAS unsigned*)&xb_words);
  const int nblk = gridDim.x, bid = blockIdx.x;
  char* ws = p.ws;
  u16* WT_EVIN = (u16*)(ws + OFF_WT_EVIN);
  u16* WT_EVOUT = (u16*)(ws + OFF_WT_EVOUT);
  u16* WT_ODIN = (u16*)(ws + OFF_WT_ODIN);
  u16* WT_ODOUT = (u16*)(ws + OFF_WT_ODOUT);
  u16* WT_Q = (u16*)(ws + OFF_WT_Q);
  u16* WT_KV = (u16*)(ws + OFF_WT_KV);
  u16* WT_O = (u16*)(ws + OFF_WT_O);
  u16* KM = (u16*)(ws + OFF_KM);
  u16* VTM = (u16*)(ws + OFF_VTM);
  float2* ROPE = (float2*)(ws + OFF_ROPE);
  float2* TW = (float2*)(ws + OFF_TW);
  float* Gt = (float*)(ws + OFF_G);
  float* NV = (float*)(ws + OFF_NV);
  float* CS = (float*)(ws + OFF_CS);
  float* MS = (float*)(ws + OFF_MS);
  u16* W3T = (u16*)(ws + OFF_W3T);
  u16* P = (u16*)(ws + R_P);
  u16* VT = (u16*)(ws + R_VT);
  u16* X1T = (u16*)(ws + R_X1T);
  u16* VHT = (u16*)(ws + R_VHT);
  u16* QP = (u16*)(ws + R_QP);
  u16* KP = (u16*)(ws + R_KP);
  u16* Y = (u16*)(ws + R_Y);
  u16* HN = Y;
  u16* ST = (u16*)(ws + R_ST);
  float* CT = (float*)(ws + R_CT);
  float* HK = (float*)(ws + R_HK);
  u16* MN = P;
  u16* HQ = P;
  u16* QC = VT;

  {
    const int tid = opaque((int)threadIdx.x), lane = tid & 63, w = tid >> 6; (void)lane; (void)w;
    tc_matrix(p.in[8], 9232, 0, 1024, 5120, WT_EVIN, smem);
    tc_matrix(p.in[8], 9232, 5136, 1024, 4096, WT_EVIN + (size_t)5120 * 1024, smem);
    tc_matrix(p.in[8] + (size_t)1024 * 9232, 9232, 0, 1024, 5120, WT_EVIN + (size_t)9216 * 1024, smem);
    tc_matrix(p.in[8] + (size_t)1024 * 9232, 9232, 5136, 1024, 4096, WT_EVIN + (size_t)9216 * 1024 + (size_t)5120 * 1024, smem);
    for (int i = 0; i < 2; ++i) {
      tc_matrix(p.in[24] + (size_t)i * 2048 * 1024, 1024, 0, 2048, 1024, WT_EVOUT + (size_t)i * 1024 * 2048, smem);
      tc_matrix(p.in[25] + (size_t)i * 1024 * 6144, 6144, 0, 1024, 6144, WT_ODIN + (size_t)i * 6144 * 1024, smem);
      tc_matrix(p.in[28] + (size_t)i * 2048 * 1024, 1024, 0, 2048, 1024, WT_ODOUT + (size_t)i * 1024 * 2048, smem);
    }
    for (int i = 0; i < 2; ++i) tc_matrix(p.in[21] + (size_t)i * 64 * 2048, 2048, 0, 64, 2048, W3T + (size_t)i * 2048 * 64, smem);
    for (int l = 0; l < 4; ++l) {
      tc_matrix(p.in[29] + (size_t)l * 1024 * 1024, 1024, 0, 1024, 1024, WT_Q + (size_t)l * 1024 * 1024, smem);
      tc_matrix(p.in[30] + (size_t)l * 1024 * 2048, 2048, 0, 1024, 2048, WT_KV + (size_t)l * 2048 * 1024, smem);
      tc_matrix(p.in[31] + (size_t)l * 1024 * 1024, 1024, 0, 1024, 1024, WT_O + (size_t)l * 1024 * 1024, smem);
    }
    for (int idx = bid * NTHR + tid; idx < 16384 * 128; idx += nblk * NTHR) {
      const int pos = idx >> 7, j = idx & 127;
      const float inv = powf(10000.f, -(float)(2 * j) / 256.f);
      const float ang = (float)pos * inv;
      double q = (double)ang * 0.15915494309189533577;
      q -= floor(q);
      float s, c;
      sincosf((float)(q * 6.283185307179586477), &s, &c);
      ROPE[idx] = make_float2(c, s);
    }
    for (int k = bid * NTHR + tid; k < 16384; k += nblk * NTHR) {
      const float x = (float)k * (1.f / 16384.f);
      TW[k] = make_float2(cospif(x), -sinpif(x));
    }
    for (int r = bid * 8 + w; r < 4 * 2304; r += nblk * 8) {
      const int l = r / 2304, m = r - l * 2304;
      const float* x = (m < 256) ? (p.in[2] + (size_t)m * 1024) : (p.in[3] + (size_t)(m - 256) * 1024);
      float hn[16];
      norm_row(x, p.in[6] + l * 1024, MN + (size_t)r * 1024, hn, lane);
    }
  }
  grid.sync();
  for (int l = 0; l < 4; ++l) {
    EpiKV e{KM + (size_t)l * 2304 * 1024, VTM + (size_t)l * 2304 * 1024};
    gemm_phase(MN + (size_t)l * 2304 * 1024, 1024, WT_KV + (size_t)l * 2048 * 1024, 1024, 1024, 2304, 2048, smem, e);
  }
  GSYNC();

  for (int layer = 0; layer < 4; ++layer) {
    const int li = layer >> 1;
    const bool even = (layer & 1) == 0;
    for (int g = 0; g < 5; ++g) {
      const Grp G = mk_grp(g);
      const int tok0 = g * GT;
      {
        const int tid = opaque((int)threadIdx.x), lane = tid & 63, w = tid >> 6; (void)lane; (void)w;
        const float* gmix = p.in[4] + layer * 1024;
        const float* Win = p.in[8] + (size_t)li * 1024 * 9232;
        const int S1 = nblk * 8;
        if (even) {
          for (int r = bid * 8 + w; r < GT; r += nblk * 8) {
            float hn[16];
            norm_row(xrow_in(p, layer, tok0 + r), gmix, HN + (size_t)r * 1024, hn, lane);
            float ga[16];
#pragma unroll
            for (int j = 0; j < 16; ++j) ga[j] = 0.f;
#pragma unroll
            for (int i = 0; i < 4; ++i)
#pragma unroll
              for (int e = 0; e < 4; ++e) {
                const float* wr = Win + (size_t)(i * 256 + lane * 4 + e) * 9232 + 5120;
                const float hv = hn[i * 4 + e];
#pragma unroll
                for (int q = 0; q < 4; ++q) {
                  const float4 wv = *(const float4*)(wr + q * 4);
                  ga[q * 4 + 0] += hv * wv.x; ga[q * 4 + 1] += hv * wv.y; ga[q * 4 + 2] += hv * wv.z; ga[q * 4 + 3] += hv * wv.w;
                }
              }
            float outv = 0.f;
#pragma unroll
            for (int j = 0; j < 16; ++j) { const float sm_ = wave_sum(ga[j]); if (lane == j) outv = sm_; }
            if (lane < 16) Gt[(size_t)r * 16 + lane] = outv;
          }
        } else {
          for (int r = bid * 8 + w; r < GT; r += 4 * S1) {
            float hn[4][16];
            norm_rows<4>([&](int k) { const int rr = r + k * S1; return xrow_in(p, layer, tok0 + (rr < GT ? rr : r)); }, gmix,
                         [&](int k) { const int rr = r + k * S1; return HN + (size_t)(rr < GT ? rr : r) * 1024; },
                         [&](int k) { return r + k * S1 < GT; }, hn, lane);
          }
        }
#ifndef NO_MLP
        if (even && g <= 1) {
          const int l_ = G.L;
          float* w1s = (float*)smem;
          float* w2s = (float*)(smem + 8448);
          float* fs = (float*)(smem + 24832);
          float* z1s = (float*)(smem + 41728);
          u16* Zb = (u16*)(smem + 74496);
          float* cst = (float*)(smem + 92928);
          const float* dl = p.in[22] + li * 2048;
          const u16* W3Tl = W3T + (size_t)li * 2048 * 64;
          __syncthreads();
          for (int e = tid; e < 33 * 64; e += NTHR) w1s[e] = p.in[15][li * 33 * 64 + e];
          for (int e = tid; e < 64 * 64; e += NTHR) w2s[e] = p.in[18][li * 64 * 64 + e];
          if (tid < 64) {
            cst[tid] = p.in[16][li * 64 + tid]; cst[64 + tid] = p.in[17][li * 64 + tid];
            cst[128 + tid] = p.in[19][li * 64 + tid]; cst[192 + tid] = p.in[20][li * 64 + tid];
          }
#ifdef PROBE_MLP
          for (int rep = 0; rep < 2; ++rep)
#endif
          for (int t = bid; t < (l_ >> 7) * 4; t += nblk) {
            const int j0 = (t >> 2) * 128, cq = t & 3;
            __syncthreads();
            for (int e = tid; e < 33 * 128; e += NTHR) {
              const int f = e >> 7, pp = e & 127;
              const int j = j0 + pp;
              float val;
              if (f == 0) val = (float)j / (float)(l_ - 1);
              else {
                const int b = (f - 1) & 15;
                const double band = 1e-4 + (double)b * ((15.0 - 1e-4) / 15.0);
                double q = band * (double)j / (double)l_;
                q -= floor(q);
                float sn, cs;
                sincosf((float)(q * 6.283185307179586477), &sn, &cs);
                val = (f <= 16) ? cs : -sn;
              }
              fs[e] = val;
            }
            __syncthreads();
            const int pp = tid & 127, kq = tid >> 7;
            {
              float a1[16];
#pragma unroll
              for (int j = 0; j < 16; ++j) a1[j] = cst[kq * 16 + j];
              for (int f = 0; f < 33; ++f) {
                const float x = fs[f * 128 + pp];
#pragma unroll
                for (int j = 0; j < 16; ++j) a1[j] += x * w1s[f * 64 + kq * 16 + j];
              }
#pragma unroll
              for (int j = 0; j < 16; ++j) z1s[(kq * 16 + j) * 128 + pp] = sinf(cst[64 + kq * 16 + j] * a1[j]);
            }
            __syncthreads();
            {
              float a2[16];
#pragma unroll
              for (int j = 0; j < 16; ++j) a2[j] = cst[128 + kq * 16 + j];
              for (int k = 0; k < 64; ++k) {
                const float x = z1s[k * 128 + pp];
#pragma unroll
                for (int j = 0; j < 16; ++j) a2[j] += x * w2s[k * 64 + kq * 16 + j];
              }
              float o[16];
#pragma unroll
              for (int j = 0; j < 16; ++j) o[j] = sinf(cst[192 + kq * 16 + j] * a2[j]);
              uint4 u0, u1;
              u0.x = pack2(o[0], o[1]); u0.y = pack2(o[2], o[3]); u0.z = pack2(o[4], o[5]); u0.w = pack2(o[6], o[7]);
              u1.x = pack2(o[8], o[9]); u1.y = pack2(o[10], o[11]); u1.z = pack2(o[12], o[13]); u1.w = pack2(o[14], o[15]);
              *(uint4*)(Zb + pp * 72 + kq * 16) = u0;
              *(uint4*)(Zb + pp * 72 + kq * 16 + 8) = u1;
            }
            __syncthreads();
            const float tden = 1.f / (float)(l_ - 1);
#pragma unroll 1
            for (int nt = cq * 2; nt < cq * 2 + 2; ++nt) {
              const int c = w * 256 + nt * 32 + (lane & 31);
              f32x16 acc[4][1];
              zero_acc<4, 1>(acc);
              wave_mma_g<4, 1, false>(acc, Zb, 72, W3Tl + (size_t)(w * 256 + nt * 32) * 64, 64, 64);
              const float ad = fabsf(dl[c]);
#pragma unroll
              for (int mi = 0; mi < 4; ++mi)
#pragma unroll
                for (int q = 0; q < 4; ++q) {
                  const int j = j0 + mi * 32 + 8 * q + 4 * (lane >> 5);
                  float v[4];
#pragma unroll
                  for (int e = 0; e < 4; ++e) v[e] = acc[mi][0][4 * q + e] * (__expf(-(float)(j + e) * tden * ad) + 0.05f);
                  if (c < 1024) *(float4*)(HK + (size_t)c * 32768 + j) = make_float4(v[0], v[1], v[2], v[3]);
                  else {
                    float* rowp = HK + (size_t)(c - 1024) * 32768;
#pragma unroll
                    for (int e = 0; e < 4; ++e) { if (j + e == 0) rowp[l_] = 0.f; else rowp[2 * l_ - j - e] = v[e]; }
                  }
                }
            }
          }
          __syncthreads();
        }
#endif
      }
      GSYNC();
#ifndef NO_PH2
      if (even) {
        EpiEvenIn e{P, VT, X1T, VHT};
        gemm_phase(HN, 1024, WT_EVIN + (size_t)li * 9216 * 1024, 1024, 1024, GT, 9216, smem, e);
        if (g <= 1) {
          const int tid = opaque((int)threadIdx.x), lane = tid & 63, w = tid >> 6; (void)lane; (void)w;
          float2* buf = (float2*)smem;
          float* red = (float*)(smem + 131072);
          const int M = G.L, logM = G.logL;
          for (int c = bid; c < 1024; c += nblk) {
            float2* row = (float2*)(HK + (size_t)c * 32768);
            float l1 = 0.f;
            for (int n0 = tid; n0 < M; n0 += 8 * NTHR) {
              float2 v[8];
#pragma unroll
              for (int j = 0; j < 8; ++j) v[j] = row[n0 + j * NTHR];
              asm volatile("" ::: "memory");
#pragma unroll
              for (int j = 0; j < 8; ++j) { buf[n0 + j * NTHR] = v[j]; l1 += fabsf(v[j].x) + fabsf(v[j].y); }
            }
            l1 = wave_sum(l1);
            if (lane == 0) red[w] = l1;
            __syncthreads();
            float tot = 0.f;
#pragma unroll
            for (int i = 0; i < 8; ++i) tot += red[i];
            const float scale = 1.f / (tot * (float)M);
            fft_fwd(buf, logM);
            for (int k = tid; k <= (M >> 1); k += NTHR) {
              const float2 a = buf[brev(k, logM)], b = buf[brev((M - k) & (M - 1), logM)];
              const float2 E = make_float2(0.5f * (a.x + b.x), 0.5f * (a.y - b.y));
              const float2 O = make_float2(0.5f * (a.y + b.y), -0.5f * (a.x - b.x));
              const float2 wk = twid((float)k / (float)(2 * M));
              const float2 wo = cmul(wk, O);
              const float2 Xk = make_float2(E.x + wo.x, E.y + wo.y);
              const float2 Xm = make_float2(E.x - wo.x, -(E.y - wo.y));
              if (k == 0) row[0] = make_float2(Xk.x * scale, Xm.x * scale);
              else { row[k] = make_float2(Xk.x * scale, Xk.y * scale); row[M - k] = make_float2(Xm.x * scale, Xm.y * scale); }
            }
            __syncthreads();
          }
        }
      } else {
        EpiOddIn e{P, VT};
        gemm_phase(HN, 1024, WT_ODIN + (size_t)li * 6144 * 1024, 1024, 1024, GT, 6144, smem, e);
      }
#endif
      GSYNC();
#ifndef NO_PH3
      {
        const int tid = opaque((int)threadIdx.x), lane = tid & 63, w = tid >> 6; (void)lane; (void)w;
        u16* Kp = (u16*)smem;
        u16* KsT = (u16*)(smem + 67584);
        float* sg = (float*)(smem + 67584 + 69632);
        float* swt = sg + 768;
#ifdef PROBE_CHUNK3
        for (int rep = 0; rep < 2; ++rep)
#endif
        for (int t = bid; t < 128 * 4; t += nblk) {
          const int ck = t >> 2, h = t & 3;
          const int lt0 = ck * 128;
          const int c = ck % G.ncs, pos0 = c * 128;
          if (even) {
            chunk_gates(Gt, p.in[11] + li * 16, lt0, h, sg);
            const float btf = sg[127], btb = sg[128];
            if (tid < 128) {
              float gf = btf - sg[tid] + sg[256 + tid], gb = btb - sg[128 + tid] + sg[384 + tid];
#pragma unroll
              for (int o = 32; o; o >>= 1) { gf = fmaxf(gf, __shfl_xor(gf, o)); gb = fmaxf(gb, __shfl_xor(gb, o)); }
              if (lane == 0) { sg[516 + w] = gf; sg[518 + w] = gb; }
            }
            __syncthreads();
            const float mf = fmaxf(sg[516], sg[517]), mb = fmaxf(sg[518], sg[519]);
            if (tid < 128) {
              swt[tid] = __expf(btf - sg[tid] + sg[256 + tid] - mf);
              swt[128 + tid] = __expf(btb - sg[128 + tid] + sg[384 + tid] - mb);
            }
            if (tid == 0) { float* cs = CS + (size_t)(ck * 4 + h) * 4; cs[0] = btf; cs[1] = mf; cs[2] = btb; cs[3] = mb; }
            const float* cw = p.in[9] + (size_t)li * 3 * 2048; const float* cb = p.in[10] + li * 2048;
#pragma unroll 1
            for (int mat = 0; mat < 2; ++mat) {
              const int cc = (tid & 31) * 8;
              const int colp = mat * 1024 + h * 256 + cc;
              float w0[8], w1[8], w2[8], wb[8];
              *(float4*)&w0[0] = *(const float4*)(cw + colp); *(float4*)&w0[4] = *(const float4*)(cw + colp + 4);
              *(float4*)&w1[0] = *(const float4*)(cw + 2048 + colp); *(float4*)&w1[4] = *(const float4*)(cw + 2048 + colp + 4);
              *(float4*)&w2[0] = *(const float4*)(cw + 4096 + colp); *(float4*)&w2[4] = *(const float4*)(cw + 4096 + colp + 4);
              *(float4*)&wb[0] = *(const float4*)(cb + colp); *(float4*)&wb[4] = *(const float4*)(cb + colp + 4);
#pragma unroll 1
              for (int bt = 0; bt < 2; ++bt) {
                uint4 vc[4], vp[4], vn[4];
#pragma unroll
                for (int k = 0; k < 4; ++k) {
                  const int r = (tid >> 5) + (bt * 4 + k) * 16;
                  const int pos = pos0 + r;
                  const u16* src = P + (size_t)(lt0 + r) * 6144 + colp;
                  vc[k] = *(const uint4*)src;
                  vp[k] = *(const uint4*)(pos > 0 ? src - 6144 : src);
                  vn[k] = *(const uint4*)(pos < G.L - 1 ? src + 6144 : src);
                }
                asm volatile("" ::: "memory");
#pragma unroll
                for (int k = 0; k < 4; ++k) {
                  const int r = (tid >> 5) + (bt * 4 + k) * 16;
                  const int pos = pos0 + r;
                  float xc[8], xp[8], xn[8], o[8];
                  unpack8(vc[k], xc); unpack8(vp[k], xp); unpack8(vn[k], xn);
                  const float mp = pos > 0 ? 1.f : 0.f, mn_ = pos < G.L - 1 ? 1.f : 0.f;
#pragma unroll
                  for (int j = 0; j < 8; ++j) {
                    const float v = w0[j] * (xp[j] * mp) + w1[j] * xc[j] + w2[j] * (xn[j] * mn_) + wb[j];
                    o[j] = siluf(v) * (mat ? 0.0625f : 1.f);
                  }
                  const uint4 pk = pack8(o);
                  if (mat == 0) *(uint4*)(QP + (size_t)(lt0 + r) * 1024 + h * 256 + cc) = pk;
                  else { *(uint4*)(KP + (size_t)(lt0 + r) * 1024 + h * 256 + cc) = pk; *(uint4*)(Kp + r * 264 + cc) = pk; }
                }
              }
            }
          } else {
            const float* dlg = p.in[26] + li * 8;
            const float lgf = logsig(dlg[h]), lgb = logsig(dlg[4 + h]);
            if (tid < 128) { swt[tid] = __expf(lgf * (float)(127 - tid)); swt[128 + tid] = __expf(lgb * (float)tid); }
#pragma unroll 1
            for (int mat = 0; mat < 2; ++mat) {
              for (int e = tid; e < 128 * 16; e += NTHR) {
                const int r = e >> 4, cc = (e & 15) * 8;
                const int pos = pos0 + r;
                const u16* src = P + (size_t)(lt0 + r) * 4096 + mat * 1024 + h * 256 + cc;
                float x1[8], x2[8], o1[8], o2[8];
                unpack8(*(const uint4*)src, x1);
                unpack8(*(const uint4*)(src + 128), x2);
                const float2* rp = ROPE + (size_t)pos * 128 + cc;
                const float sc = mat ? 1.f : 0.0625f;
#pragma unroll
                for (int j = 0; j < 8; ++j) {
                  const float2 cs = rp[j];
                  o1[j] = (x1[j] * cs.x - x2[j] * cs.y) * sc;
                  o2[j] = (x1[j] * cs.y + x2[j] * cs.x) * sc;
                }
                const uint4 p1 = pack8(o1), p2 = pack8(o2);
                u16* dst = (mat == 0 ? QP : KP) + (size_t)(lt0 + r) * 1024 + h * 256 + cc;
                *(uint4*)dst = p1; *(uint4*)(dst + 128) = p2;
                if (mat) { *(uint4*)(Kp + r * 264 + cc) = p1; *(uint4*)(Kp + r * 264 + cc + 128) = p2; }
              }
            }
          }
          __syncthreads();
          for (int dir = 0; dir < 2; ++dir) {
            for (int e = tid; e < 256 * 16; e += NTHR) {
              const int d = e & 255, sc = e >> 8;
              float f[8];
#pragma unroll
              for (int j = 0; j < 8; ++j) f[j] = bf2f(Kp[(sc * 8 + j) * 264 + d]) * swt[dir * 128 + sc * 8 + j];
              *(uint4*)(KsT + d * 136 + sc * 8) = pack8(f);
            }
            __syncthreads();
            const int wm = w >> 1, wn = w & 1;
            const int nvh = even ? 1 : 2;
            for (int vh = 0; vh < nvh * 2; ++vh) {
              const int nh = vh & 1, vq = vh >> 1;
              const int lane_o = opaque(lane);
              f32x16 acc[2][2];
              zero_acc<2, 2>(acc);
              const int vrow0 = even ? (h * 256) : (h * 512 + vq * 256);
              wave_mma_g<2, 2, false>(acc, KsT + (wm * 64) * 136, 136, VT + (size_t)(vrow0 + wn * 128 + nh * 64) * GT + lt0, GT, 128);
              u16* stp = even ? (ST + ((size_t)((ck * 4 + h) * 2 + dir) << 16))
                              : (ST + ((size_t)((ck * 4 + h) * 2 + dir) << 17) + (size_t)vq * 65536);
              const int hh_o = lane_o >> 5;
#pragma unroll
              for (int mi = 0; mi < 2; ++mi)
#pragma unroll
                for (int ni = 0; ni < 2; ++ni)
#pragma unroll
                  for (int pq = 0; pq < 2; ++pq) {
                    const unsigned e0 = pack2(acc[mi][ni][8 * pq], acc[mi][ni][8 * pq + 1]), e1 = pack2(acc[mi][ni][8 * pq + 2], acc[mi][ni][8 * pq + 3]);
                    const unsigned o0 = pack2(acc[mi][ni][8 * pq + 4], acc[mi][ni][8 * pq + 5]), o1 = pack2(acc[mi][ni][8 * pq + 6], acc[mi][ni][8 * pq + 7]);
                    const unsigned s0 = hh_o ? e0 : o0, s1 = hh_o ? e1 : o1;
                    const unsigned r0 = (unsigned)__shfl_xor((int)s0, 32), r1 = (unsigned)__shfl_xor((int)s1, 32);
                    uint4 u;
                    if (hh_o) { u.x = r0; u.y = r1; u.z = o0; u.w = o1; } else { u.x = e0; u.y = e1; u.z = r0; u.w = r1; }
                    const int d0 = wm * 64 + mi * 32 + 16 * pq + 8 * hh_o;
                    const int v = wn * 128 + nh * 64 + ni * 32 + (lane_o & 31);
                    *(uint4*)(stp + v * 256 + d0) = u;
                  }
            }
            if (even && tid < 256) {
              float a = 0.f;
              for (int s = 0; s < 128; ++s) a += bf2f(KsT[tid * 136 + s]);
              NV[(size_t)((ck * 4 + h) * 2 + dir) * 256 + tid] = a;
            }
            __syncthreads();
          }
        }
      }
#endif
      GSYNC();
#ifndef NO_PH4
      {
        const int tid = opaque((int)threadIdx.x), lane = tid & 63, w = tid >> 6; (void)lane; (void)w;
        const int nchain = G.nb * 4 * 2;
        if (even) {
#pragma unroll 1
          for (int pass = 0; pass < 2; ++pass) {
          if ((pass == 0) == ((bid & 8) == 0)) {
          for (int it = bid * NTHR + tid; it < nchain * 16384; it += nblk * NTHR) {
            const int ch = it >> 14, e = it & 16383;
            const int bl = ch >> 3, h = (ch >> 1) & 3, dir = ch & 1;
            float c0 = 0.f, c1 = 0.f, c2 = 0.f, c3 = 0.f, m = 0.f;
            for (int cc0 = 0; cc0 < G.ncs; cc0 += 8) {
              uint2 u[8];
              uint2* ptr[8];
              float2 csv[8];
#pragma unroll
              for (int j = 0; j < 8; ++j) {
                const int ck = bl * G.ncs + (dir ? G.ncs - 1 - (cc0 + j) : (cc0 + j));
                ptr[j] = (uint2*)(ST + ((size_t)((ck * 4 + h) * 2 + dir) << 16)) + e;
                u[j] = *ptr[j];
                csv[j] = *(const float2*)(CS + (size_t)(ck * 4 + h) * 4 + dir * 2);
              }
#pragma unroll
              for (int j = 0; j < 8; ++j) {
                const float bt = csv[j].x, ml = csv[j].y;
                const float mn = fmaxf(bt + m, ml);
                const float a = __expf(bt + m - mn), b = __expf(ml - mn);
                uint2 o; o.x = pack2(c0, c1); o.y = pack2(c2, c3);
                *ptr[j] = o;
                c0 = a * c0 + b * __uint_as_float(u[j].x << 16); c1 = a * c1 + b * __uint_as_float(u[j].x & 0xffff0000u);
                c2 = a * c2 + b * __uint_as_float(u[j].y << 16); c3 = a * c3 + b * __uint_as_float(u[j].y & 0xffff0000u);
                m = mn;
              }
            }
          }
          for (int it = bid * NTHR + tid; it < nchain * 256; it += nblk * NTHR) {
            const int ch = it >> 8, d = it & 255;
            const int bl = ch >> 3, h = (ch >> 1) & 3, dir = ch & 1;
            float c0 = 0.f, m = 0.f;
            for (int cc0 = 0; cc0 < G.ncs; cc0 += 8) {
              float u[8];
              float* ptr[8];
              float2 csv[8];
#pragma unroll
              for (int j = 0; j < 8; ++j) {
                const int ck = bl * G.ncs + (dir ? G.ncs - 1 - (cc0 + j) : (cc0 + j));
                ptr[j] = NV + (size_t)((ck * 4 + h) * 2 + dir) * 256 + d;
                u[j] = *ptr[j];
                csv[j] = *(const float2*)(CS + (size_t)(ck * 4 + h) * 4 + dir * 2);
              }
#pragma unroll
              for (int j = 0; j < 8; ++j) {
                const int ck = bl * G.ncs + (dir ? G.ncs - 1 - (cc0 + j) : (cc0 + j));
                const float bt = csv[j].x, ml = csv[j].y;
                const float mn = fmaxf(bt + m, ml);
                const float a = __expf(bt + m - mn), b = __expf(ml - mn);
                *ptr[j] = c0;
                if (d == 0) MS[(ck * 4 + h) * 2 + dir] = m;
                c0 = a * c0 + b * u[j];
                m = mn;
              }
            }
          }
          } else
          {
            float2* buf = (float2*)smem;
            const int M = G.L, logM = G.logL;
            const float* hcw = p.in[13] + (size_t)li * 3 * 3072; const float* hcb = p.in[14] + li * 3072;
            const float* skp = p.in[23] + li * 1024;
#ifdef PROBE_FFT
            for (int rep = 0; rep < 2; ++rep)
#endif
            for (int t = bid; t < G.nb * 1024; t += nblk) {
              const int bl = t >> 10, c = t & 1023;
              const u16* x1r = X1T + (size_t)c * GT + bl * M;
              const u16* vhr = VHT + (size_t)c * GT + bl * M;
              const float a0 = hcw[1024 + c], a1 = hcw[3072 + 1024 + c], a2 = hcw[6144 + 1024 + c], ab = hcb[1024 + c];
              const float v0 = hcw[2048 + c], v1 = hcw[3072 + 2048 + c], v2 = hcw[6144 + 2048 + c], vb = hcb[2048 + c];
              const float skip = skp[c];
              const float2* Hr = (const float2*)(HK + (size_t)c * 32768);
              for (int n8 = tid; n8 < (M >> 3); n8 += NTHR) {
                const int j0 = n8 * 8;
                float xa[8], xv[8], tt[8];
                unpack8(*(const uint4*)(x1r + j0), xa);
                unpack8(*(const uint4*)(vhr + j0), xv);
                const float pa = j0 > 0 ? bf2f(x1r[j0 - 1]) : 0.f, na = j0 + 8 < M ? bf2f(x1r[j0 + 8]) : 0.f;
                const float pv = j0 > 0 ? bf2f(vhr[j0 - 1]) : 0.f, nv = j0 + 8 < M ? bf2f(vhr[j0 + 8]) : 0.f;
#pragma unroll
                for (int j = 0; j < 8; ++j) {
                  const float xl = j ? xa[j - 1] : pa, xr = j < 7 ? xa[j + 1] : na;
                  const float vl = j ? xv[j - 1] : pv, vr = j < 7 ? xv[j + 1] : nv;
                  tt[j] = (a0 * xl + a1 * xa[j] + a2 * xr + ab) * (v0 * vl + v1 * xv[j] + v2 * vr + vb);
                }
#pragma unroll
                for (int q = 0; q < 4; ++q) buf[n8 * 4 + q] = make_float2(tt[2 * q], tt[2 * q + 1]);
              }
              for (int n = (M >> 1) + tid; n < M; n += NTHR) buf[n] = make_float2(0.f, 0.f);
              __syncthreads();
              fft_fwd(buf, logM);
              for (int k0 = tid; k0 <= (M >> 1); k0 += 4 * NTHR) {
                float2 hk[4], hm[4];
#pragma unroll
                for (int jb = 0; jb < 4; ++jb) {
                  const int k = min(k0 + jb * NTHR, M >> 1);
                  hk[jb] = Hr[k]; hm[jb] = Hr[(M - k) & (M - 1)];
                }
                asm volatile("" ::: "memory");
#pragma unroll
                for (int jb = 0; jb < 4; ++jb) {
                const int k = k0 + jb * NTHR;
                if (k <= (M >> 1)) {
                const int ia = brev(k, logM), ib = brev((M - k) & (M - 1), logM);
                const float2 a = buf[ia], b = buf[ib];
                const float2 E = make_float2(0.5f * (a.x + b.x), 0.5f * (a.y - b.y));
                const float2 O = make_float2(0.5f * (a.y + b.y), -0.5f * (a.x - b.x));
                const float2 wk = twid((float)k / (float)(2 * M));
                const float2 wo = cmul(wk, O);
                const float2 Xk = make_float2(E.x + wo.x, E.y + wo.y);
                const float2 Xm = make_float2(E.x - wo.x, -(E.y - wo.y));
                float2 Yk, Ym;
                if (k == 0) { const float2 h0 = hk[jb]; Yk = make_float2(Xk.x * h0.x, 0.f); Ym = make_float2(Xm.x * h0.y, 0.f); }
                else { Yk = cmul(Xk, hk[jb]); Ym = cmul(Xm, hm[jb]); }
                const float2 E2 = make_float2(0.5f * (Yk.x + Ym.x), 0.5f * (Yk.y - Ym.y));
                const float2 Dd = make_float2(0.5f * (Yk.x - Ym.x), 0.5f * (Yk.y + Ym.y));
                const float2 O2 = cmul(make_float2(wk.x, -wk.y), Dd);
                buf[ia] = make_float2(E2.x - O2.y, E2.y + O2.x);
                if (k != 0) buf[ib] = make_float2(E2.x + O2.y, -E2.y + O2.x);
                }
                }
              }
              __syncthreads();
              fft_inv(buf, logM);
              float* ctr = CT + (size_t)c * GT + bl * M;
              for (int n8 = tid; n8 < (M >> 3); n8 += NTHR) {
                const int j0 = n8 * 8;
                float xa[8], xv[8], o[8];
                unpack8(*(const uint4*)(x1r + j0), xa);
                unpack8(*(const uint4*)(vhr + j0), xv);
                const float pa = j0 > 0 ? bf2f(x1r[j0 - 1]) : 0.f, na = j0 + 8 < M ? bf2f(x1r[j0 + 8]) : 0.f;
                const float pv = j0 > 0 ? bf2f(vhr[j0 - 1]) : 0.f, nv = j0 + 8 < M ? bf2f(vhr[j0 + 8]) : 0.f;
#pragma unroll
                for (int j = 0; j < 8; ++j) {
                  const float xl = j ? xa[j - 1] : pa, xr = j < 7 ? xa[j + 1] : na;
                  const float vl = j ? xv[j - 1] : pv, vr = j < 7 ? xv[j + 1] : nv;
                  const float tv = (a0 * xl + a1 * xa[j] + a2 * xr + ab) * (v0 * vl + v1 * xv[j] + v2 * vr + vb);
                  const float2 z = buf[n8 * 4 + (j >> 1)];
                  o[j] = ((j & 1) ? z.y : z.x) + skip * tv;
                }
                *(float4*)(ctr + j0) = make_float4(o[0], o[1], o[2], o[3]);
                *(float4*)(ctr + j0 + 4) = make_float4(o[4], o[5], o[6], o[7]);
              }
              __syncthreads();
            }
          }
          }
        } else {
          const float* dlg = p.in[26] + li * 8;
          for (int it = bid * NTHR + tid; it < nchain * 32768; it += nblk * NTHR) {
            const int ch = it >> 15, e = it & 32767;
            const int bl = ch >> 3, h = (ch >> 1) & 3, dir = ch & 1;
            const float a = __expf(128.f * logsig(dlg[dir * 4 + h]));
            float c0 = 0.f, c1 = 0.f, c2 = 0.f, c3 = 0.f;
            for (int cc0 = 0; cc0 < G.ncs; cc0 += 8) {
              uint2 u[8];
              uint2* ptr[8];
#pragma unroll
              for (int j = 0; j < 8; ++j) {
                const int ck = bl * G.ncs + (dir ? G.ncs - 1 - (cc0 + j) : (cc0 + j));
                ptr[j] = (uint2*)(ST + ((size_t)((ck * 4 + h) * 2 + dir) << 17)) + e;
                u[j] = *ptr[j];
              }
#pragma unroll
              for (int j = 0; j < 8; ++j) {
                uint2 o; o.x = pack2(c0, c1); o.y = pack2(c2, c3);
                *ptr[j] = o;
                c0 = a * c0 + __uint_as_float(u[j].x << 16); c1 = a * c1 + __uint_as_float(u[j].x & 0xffff0000u);
                c2 = a * c2 + __uint_as_float(u[j].y << 16); c3 = a * c3 + __uint_as_float(u[j].y & 0xffff0000u);
              }
            }
          }
        }
      }
#endif
      GSYNC();
#ifndef NO_PH5
      {
        const int tid = opaque((int)threadIdx.x), lane = tid & 63, w = tid >> 6; (void)lane; (void)w;
        float* Ss = (float*)smem;
        u16* Ps = (u16*)(smem + 33792);
        u16* Qf = (u16*)(smem + 33792 + 17408);
        u16* Qb = (u16*)(smem + 33792 + 17408 + 33792);
        float* Os = (float*)smem;
        float* sg = (float*)(smem + 135168);
        float* snf = sg + 768;
        float* sq = snf + 512;
#ifdef PROBE_CHUNK5
        for (int rep = 0; rep < 2; ++rep)
#endif
        const bool paired = (nblk == 256);
        for (int t = paired ? ((((bid >> 3) >> 1) << 3) + (bid & 7)) : bid; t < 128 * 4; t += (paired ? 128 : nblk)) {
          const int ck = t >> 2, h = t & 3;
          const int lt0 = ck * 128;
          const int tid_o = tid;
          const int wm = w >> 2, wn = w & 3;
          const int row = tid_o >> 3, sub = tid_o & 7;
          float lgf = 0.f, lgb = 0.f, mstf = 0.f, mstb = 0.f;
          if (even) {
            chunk_gates(Gt, p.in[11] + li * 16, lt0, h, sg);
            snf[tid] = NV[(size_t)((ck * 4 + h) * 2 + (tid >> 8)) * 256 + (tid & 255)];
            mstf = MS[(ck * 4 + h) * 2]; mstb = MS[(ck * 4 + h) * 2 + 1];
            __syncthreads();
          } else {
            const float* dlg = p.in[26] + li * 8;
            lgf = logsig(dlg[h]); lgb = logsig(dlg[4 + h]);
          }
#pragma unroll 1
          for (int half = paired ? ((bid >> 3) & 1) : 0; half < (paired ? (((bid >> 3) & 1) + 1) : 2); ++half) {
          const int ltr = lt0 + half * 64;
          const int tau = half * 64 + row;
          {
            const int tidf = opaque(tid); const int lane = tidf & 63, wq_ = tidf >> 6, wm = wq_ >> 2, wn = wq_ & 3, row = tidf >> 3, sub = tidf & 7; const int tau = half * 64 + row; (void)lane; (void)wm; (void)wn; (void)row; (void)sub; (void)tau;
            f32x16 acc[1][1];
            zero_acc<1, 1>(acc);
            wave_mma_g<1, 1, true>(acc, QP + (size_t)(ltr + wm * 32) * 1024 + h * 256, 1024, KP + (size_t)(lt0 + wn * 32) * 1024 + h * 256, 1024, 256);
#pragma unroll
            for (int r = 0; r < 16; ++r) {
              const int rr = wm * 32 + (r & 3) + 8 * (r >> 2) + 4 * (lane >> 5);
              Ss[rr * 132 + wn * 32 + (lane & 31)] = acc[0][0][r];
            }
          }
          if (even) {
            const int tidf = opaque(tid); const int lane = tidf & 63, wq_ = tidf >> 6, wm = wq_ >> 2, wn = wq_ & 3, row = tidf >> 3, sub = tidf & 7; const int tau = half * 64 + row; (void)lane; (void)wm; (void)wn; (void)row; (void)sub; (void)tau;
            const u16* qr = QP + (size_t)(ltr + row) * 1024 + h * 256 + sub * 32;
            float sf = 0.f, sb = 0.f;
#pragma unroll
            for (int q4 = 0; q4 < 4; ++q4) {
              float f[8];
              unpack8(*(const uint4*)(qr + q4 * 8), f);
#pragma unroll
              for (int j = 0; j < 8; ++j) { sf += f[j] * snf[sub * 32 + q4 * 8 + j]; sb += f[j] * snf[256 + sub * 32 + q4 * 8 + j]; }
            }
            sf += __shfl_xor(sf, 1); sf += __shfl_xor(sf, 2); sf += __shfl_xor(sf, 4);
            sb += __shfl_xor(sb, 1); sb += __shfl_xor(sb, 2); sb += __shfl_xor(sb, 4);
            if (sub == 0) { sq[row] = sf; sq[64 + row] = sb; }
          }
          __syncthreads();
          {
            const int tidf = opaque(tid); const int lane = tidf & 63, wq_ = tidf >> 6, wm = wq_ >> 2, wn = wq_ & 3, row = tidf >> 3, sub = tidf & 7; const int tau = half * 64 + row; (void)lane; (void)wm; (void)wn; (void)row; (void)sub; (void)tau;
            float pf[16], pb[16];
            float af, ab;
            if (even) {
              const float bcf = sg[tau], bcb = sg[128 + tau];
              float mf = -1e30f, mb = -1e30f;
#pragma unroll
              for (int j = 0; j < 16; ++j) {
                const int s = sub * 16 + j;
                if (s <= tau) mf = fmaxf(mf, bcf - sg[s] + sg[256 + s]);
                if (s >= tau) mb = fmaxf(mb, bcb - sg[128 + s] + sg[384 + s]);
              }
              mf = fmaxf(mf, __shfl_xor(mf, 1)); mf = fmaxf(mf, __shfl_xor(mf, 2)); mf = fmaxf(mf, __shfl_xor(mf, 4));
              mb = fmaxf(mb, __shfl_xor(mb, 1)); mb = fmaxf(mb, __shfl_xor(mb, 2)); mb = fmaxf(mb, __shfl_xor(mb, 4));
              const float interf = bcf + mstf, interb = bcb + mstb;
              mf = fmaxf(mf, interf); mb = fmaxf(mb, interb);
              float sumf = 0.f, sumb = 0.f;
#pragma unroll
              for (int j = 0; j < 16; ++j) {
                const int s = sub * 16 + j;
                const float sv = Ss[row * 132 + s];
                pf[j] = (s <= tau) ? sv * __expf(bcf - sg[s] + sg[256 + s] - mf) : 0.f;
                pb[j] = (s >= tau) ? sv * __expf(bcb - sg[128 + s] + sg[384 + s] - mb) : 0.f;
                sumf += pf[j]; sumb += pb[j];
              }
              sumf += __shfl_xor(sumf, 1); sumf += __shfl_xor(sumf, 2); sumf += __shfl_xor(sumf, 4);
              sumb += __shfl_xor(sumb, 1); sumb += __shfl_xor(sumb, 2); sumb += __shfl_xor(sumb, 4);
              const float scf = __expf(interf - mf), scb = __expf(interb - mb);
              const float denf = sumf + scf * sq[row], denb = sumb + scb * sq[64 + row];
              const float nf = fmaxf(fabsf(denf), __expf(-mf)), nbv = fmaxf(fabsf(denb), __expf(-mb));
              const float inf_ = 1.f / nf, inb = 1.f / nbv;
              af = scf * inf_; ab = scb * inb;
#pragma unroll
              for (int j = 0; j < 16; ++j) pf[j] = pf[j] * inf_ + pb[j] * inb;
            } else {
#pragma unroll
              for (int j = 0; j < 16; ++j) {
                const int s = sub * 16 + j;
                const float sv = Ss[row * 132 + s];
                float wgt = 0.f;
                if (s <= tau) wgt += __expf(lgf * (float)(tau - s));
                if (s >= tau) wgt += __expf(lgb * (float)(s - tau));
                pf[j] = sv * wgt;
              }
              af = __expf(lgf * (float)(tau + 1)); ab = __expf(lgb * (float)(128 - tau));
            }
            uint4 u0, u1;
            u0.x = pack2(pf[0], pf[1]); u0.y = pack2(pf[2], pf[3]); u0.z = pack2(pf[4], pf[5]); u0.w = pack2(pf[6], pf[7]);
            u1.x = pack2(pf[8], pf[9]); u1.y = pack2(pf[10], pf[11]); u1.z = pack2(pf[12], pf[13]); u1.w = pack2(pf[14], pf[15]);
            *(uint4*)(Ps + row * 136 + sub * 16) = u0;
            *(uint4*)(Ps + row * 136 + sub * 16 + 8) = u1;
            if (sub == 0) { sq[128 + row] = af; sq[192 + row] = ab; }
          }
          __syncthreads();
          uint4 qv[4];
          {
            const int e0 = opaque(tid);
#pragma unroll
            for (int it = 0; it < 4; ++it) {
              const int e = e0 + it * NTHR;
              qv[it] = *(const uint4*)(QP + (size_t)(ltr + (e >> 5)) * 1024 + h * 256 + (e & 31) * 8);
            }
            asm volatile("" ::: "memory");
          }
          for (int e = opaque(tid), it = 0; e < 64 * 32; e += NTHR, ++it) {
            const int r = e >> 5, cc = (e & 31) * 8;
            float f[8], o1[8], o2[8];
            unpack8(it == 0 ? qv[0] : (it == 1 ? qv[1] : (it == 2 ? qv[2] : qv[3])), f);
            const float a1 = sq[128 + r], a2 = sq[192 + r];
#pragma unroll
            for (int j = 0; j < 8; ++j) { o1[j] = f[j] * a1; o2[j] = f[j] * a2; }
            *(uint4*)(Qf + r * 264 + cc) = pack8(o1);
            *(uint4*)(Qb + r * 264 + cc) = pack8(o2);
          }
          __syncthreads();
          if (even) {
            const int tidf = opaque(tid); const int lane = tidf & 63, wq_ = tidf >> 6, wm = wq_ >> 2, wn = wq_ & 3, row = tidf >> 3, sub = tidf & 7; const int tau = half * 64 + row; (void)lane; (void)wm; (void)wn; (void)row; (void)sub; (void)tau;
            f32x16 acc[1][2];
            zero_acc<1, 2>(acc);
            const u16* stf = ST + ((size_t)((ck * 4 + h) * 2) << 16);
            const u16* stb = stf + 65536;
            wave_mma_g<1, 2, false>(acc, Ps + wm * 32 * 136, 136, VT + (size_t)(h * 256 + wn * 64) * GT + lt0, GT, 128);
            wave_mma_g<1, 2, false>(acc, Qf + wm * 32 * 264, 264, stf + (size_t)(wn * 64) * 256, 256, 256);
            wave_mma_g<1, 2, false>(acc, Qb + wm * 32 * 264, 264, stb + (size_t)(wn * 64) * 256, 256, 256);
#ifdef PROBE_OGEMM
            {
              f32x16 accd[1][2];
              zero_acc<1, 2>(accd);
              wave_mma_g<1, 2, false>(accd, Ps + wm * 32 * 136, 136, VT + (size_t)(h * 256 + wn * 64) * GT + lt0, GT, 128);
              wave_mma_g<1, 2, false>(accd, Qf + wm * 32 * 264, 264, stf + (size_t)(wn * 64) * 256, 256, 256);
              wave_mma_g<1, 2, false>(accd, Qb + wm * 32 * 264, 264, stb + (size_t)(wn * 64) * 256, 256, 256);
              if (p.ws == nullptr) {
#pragma unroll
                for (int ni = 0; ni < 2; ++ni)
#pragma unroll
                  for (int r = 0; r < 16; ++r) acc[0][ni][r] += accd[0][ni][r];
              }
            }
#endif
            __syncthreads();
#pragma unroll
            for (int ni = 0; ni < 2; ++ni)
#pragma unroll
              for (int r = 0; r < 16; ++r) {
                const int rr = wm * 32 + (r & 3) + 8 * (r >> 2) + 4 * (lane >> 5);
                Os[rr * 260 + wn * 64 + ni * 32 + (lane & 31)] = acc[0][ni][r];
              }
            __syncthreads();
            {
            const int tidf = opaque(tid); const int lane = tidf & 63, wq_ = tidf >> 6, wm = wq_ >> 2, wn = wq_ & 3, row = tidf >> 3, sub = tidf & 7; const int tau = half * 64 + row; (void)lane; (void)wm; (void)wn; (void)row; (void)sub; (void)tau;
            float s1 = 0.f;
#pragma unroll
            for (int j = 0; j < 32; ++j) s1 += Os[row * 260 + (j >> 3) * 64 + sub * 8 + (j & 7)];
            s1 += __shfl_xor(s1, 1); s1 += __shfl_xor(s1, 2); s1 += __shfl_xor(s1, 4);
            const float mu = s1 * (1.f / 256.f);
            float s2 = 0.f;
#pragma unroll
            for (int j = 0; j < 32; ++j) { const float d = Os[row * 260 + (j >> 3) * 64 + sub * 8 + (j & 7)] - mu; s2 += d * d; }
            s2 += __shfl_xor(s2, 1); s2 += __shfl_xor(s2, 2); s2 += __shfl_xor(s2, 4);
            const float rstd = rsqrtf(s2 * (1.f / 256.f) + 1e-5f);
            const float* gn = p.in[12] + li * 1024 + h * 256;
            const u16* prow = P + (size_t)(ltr + row) * 6144;
            uint4 voa[4], vza[4];
            float4 vg[4][2];
#pragma unroll
            for (int jj = 0; jj < 4; ++jj) {
              const int v = jj * 64 + sub * 8;
              voa[jj] = *(const uint4*)(prow + 2048 + h * 256 + v);
              vza[jj] = *(const uint4*)(prow + 3072 + h * 256 + v);
              vg[jj][0] = *(const float4*)(gn + v); vg[jj][1] = *(const float4*)(gn + v + 4);
            }
            asm volatile("" ::: "memory");
#pragma unroll
            for (int jj = 0; jj < 4; ++jj) {
              const int v = jj * 64 + sub * 8;
              float oa[8], za[8], o[8];
              unpack8(voa[jj], oa);
              unpack8(vza[jj], za);
              const float gv[8] = {vg[jj][0].x, vg[jj][0].y, vg[jj][0].z, vg[jj][0].w, vg[jj][1].x, vg[jj][1].y, vg[jj][1].z, vg[jj][1].w};
#pragma unroll
              for (int j = 0; j < 8; ++j)
                o[j] = (Os[row * 260 + v + j] - mu) * rstd * gv[j] * sigmf(oa[j]) * siluf(za[j]);
              *(uint4*)(Y + (size_t)(ltr + row) * 2048 + h * 256 + v) = pack8(o);
            }
            }
          } else {
            const int tidf = opaque(tid); const int lane = tidf & 63, wq_ = tidf >> 6, wm = wq_ >> 2, wn = wq_ & 3, row = tidf >> 3, sub = tidf & 7; const int tau = half * 64 + row; (void)lane; (void)wm; (void)wn; (void)row; (void)sub; (void)tau;

            f32x16 acc[1][4];
            zero_acc<1, 4>(acc);
            const u16* stf = ST + ((size_t)((ck * 4 + h) * 2) << 17);
            const u16* stb = stf + 131072;
            wave_mma_g<1, 4, false>(acc, Ps + wm * 32 * 136, 136, VT + (size_t)(h * 512 + wn * 128) * GT + lt0, GT, 128);
            wave_mma_g<1, 4, false>(acc, Qf + wm * 32 * 264, 264, stf + (size_t)(wn * 128) * 256, 256, 256);
            wave_mma_g<1, 4, false>(acc, Qb + wm * 32 * 264, 264, stb + (size_t)(wn * 128) * 256, 256, 256);
#ifdef PROBE_OGEMM
            {
              f32x16 accd[1][4];
              zero_acc<1, 4>(accd);
              wave_mma_g<1, 4, false>(accd, Ps + wm * 32 * 136, 136, VT + (size_t)(h * 512 + wn * 128) * GT + lt0, GT, 128);
              wave_mma_g<1, 4, false>(accd, Qf + wm * 32 * 264, 264, stf + (size_t)(wn * 128) * 256, 256, 256);
              wave_mma_g<1, 4, false>(accd, Qb + wm * 32 * 264, 264, stb + (size_t)(wn * 128) * 256, 256, 256);
              if (p.ws == nullptr) {
#pragma unroll
                for (int ni = 0; ni < 4; ++ni)
#pragma unroll
                  for (int r = 0; r < 16; ++r) acc[0][ni][r] += accd[0][ni][r];
              }
            }
#endif
            __syncthreads();
#pragma unroll
            for (int ni = 0; ni < 4; ++ni)
#pragma unroll
              for (int r = 0; r < 16; ++r) {
                const int rr = wm * 32 + (r & 3) + 8 * (r >> 2) + 4 * (lane >> 5);
                Os[rr * 516 + wn * 128 + ni * 32 + (lane & 31)] = acc[0][ni][r];
              }
            __syncthreads();
            {
            const int tidf = opaque(tid); const int lane = tidf & 63, wq_ = tidf >> 6, wm = wq_ >> 2, wn = wq_ & 3, row = tidf >> 3, sub = tidf & 7; const int tau = half * 64 + row; (void)lane; (void)wm; (void)wn; (void)row; (void)sub; (void)tau;
            float s1 = 0.f;
#pragma unroll
            for (int j = 0; j < 64; ++j) s1 += Os[row * 516 + (j >> 3) * 64 + sub * 8 + (j & 7)];
            s1 += __shfl_xor(s1, 1); s1 += __shfl_xor(s1, 2); s1 += __shfl_xor(s1, 4);
            const float mu = s1 * (1.f / 512.f);
            float s2 = 0.f;
#pragma unroll
            for (int j = 0; j < 64; ++j) { const float d = Os[row * 516 + (j >> 3) * 64 + sub * 8 + (j & 7)] - mu; s2 += d * d; }
            s2 += __shfl_xor(s2, 1); s2 += __shfl_xor(s2, 2); s2 += __shfl_xor(s2, 4);
            const float rstd = rsqrtf(s2 * (1.f / 512.f) + 1e-5f);
            const float* gn = p.in[27] + li * 2048 + h * 512;
            const u16* prow = P + (size_t)(ltr + row) * 4096 + 2048 + h * 512;
#pragma unroll 1
            for (int jb = 0; jb < 2; ++jb) {
              uint4 vgg[4];
              float4 vg[4][2];
#pragma unroll
              for (int j4 = 0; j4 < 4; ++j4) {
                const int v = (jb * 4 + j4) * 64 + sub * 8;
                vgg[j4] = *(const uint4*)(prow + v);
                vg[j4][0] = *(const float4*)(gn + v); vg[j4][1] = *(const float4*)(gn + v + 4);
              }
              asm volatile("" ::: "memory");
#pragma unroll
              for (int j4 = 0; j4 < 4; ++j4) {
                const int v = (jb * 4 + j4) * 64 + sub * 8;
                float gg[8], o[8];
                unpack8(vgg[j4], gg);
                const float gv[8] = {vg[j4][0].x, vg[j4][0].y, vg[j4][0].z, vg[j4][0].w, vg[j4][1].x, vg[j4][1].y, vg[j4][1].z, vg[j4][1].w};
#pragma unroll
                for (int j = 0; j < 8; ++j) o[j] = (Os[row * 516 + v + j] - mu) * rstd * gv[j] * siluf(gg[j]);
                *(uint4*)(Y + (size_t)(ltr + row) * 2048 + h * 512 + v) = pack8(o);
              }
            }
            }
          }
          __syncthreads();
          }
        }
        if (even) {
          float* lds = (float*)smem;
          const float* hcw = p.in[13] + (size_t)li * 3 * 3072; const float* hcb = p.in[14] + li * 3072;
#ifdef PROBE_FIN
          for (int rep = 0; rep < 2; ++rep)
#endif
          for (int t = bid; t < 256 * 16; t += nblk) {
            const int tt0 = (t >> 4) * 64, c0 = (t & 15) * 64;
            {
              float cv[8];
#pragma unroll
              for (int i = 0; i < 8; ++i) {
                const int e = tid + i * 512, c2 = e >> 6, tt = e & 63;
                cv[i] = CT[(size_t)(c0 + c2) * GT + tt0 + tt];
              }
              asm volatile("" ::: "memory");
#pragma unroll
              for (int i = 0; i < 8; ++i) {
                const int e = tid + i * 512, c2 = e >> 6, tt = e & 63;
                lds[c2 * 65 + tt] = cv[i];
              }
            }
            __syncthreads();
            {
              const int tq = opaque(tid);
              const int cc = tq & 63, c = c0 + cc, ttb = tq >> 6;
              const float w0 = hcw[c], w1 = hcw[3072 + c], w2 = hcw[6144 + c], wbb = hcb[c];
#pragma unroll 1
              for (int bt = 0; bt < 2; ++bt) {
                u16 rc[4], rp[4], rn[4], rz[4];
#pragma unroll
                for (int i = 0; i < 4; ++i) {
                  const int lt = tt0 + ttb + (bt * 4 + i) * 8;
                  const int pos = lt & (G.L - 1);
                  const u16* pr = P + (size_t)lt * 6144 + c;
                  rc[i] = pr[4096];
                  rp[i] = pr[4096 - (pos > 0 ? 6144 : 0)];
                  rn[i] = pr[4096 + (pos < G.L - 1 ? 6144 : 0)];
                  rz[i] = pr[5120];
                }
                asm volatile("" ::: "memory");
#pragma unroll
                for (int i = 0; i < 4; ++i) {
                  const int tt = ttb + (bt * 4 + i) * 8;
                  const int lt = tt0 + tt;
                  const int pos = lt & (G.L - 1);
                  const float xp = pos > 0 ? bf2f(rp[i]) : 0.f;
                  const float xn = pos < G.L - 1 ? bf2f(rn[i]) : 0.f;
                  const float x0 = w0 * xp + w1 * bf2f(rc[i]) + w2 * xn + wbb;
                  Y[(size_t)lt * 2048 + 1024 + c] = f2bf(x0 * lds[cc * 65 + tt] * siluf(bf2f(rz[i])));
                }
              }
            }
            __syncthreads();
          }
        }
      }
#endif
      GSYNC();
#ifndef NO_PH6
      {
        EpiResid e{p, layer, tok0};
        gemm_phase(Y, 2048, (even ? WT_EVOUT : WT_ODOUT) + (size_t)li * 1024 * 2048, 2048, 2048, GT, 1024, smem, e);
      }
#endif
      GSYNC();
#ifndef NO_CA
    {
      const int tid = opaque((int)threadIdx.x), lane = tid & 63, w = tid >> 6; (void)lane; (void)w;
      const float* gca = p.in[5] + layer * 1024;
      const int S = nblk * 8;
      for (int r = bid * 8 + w; r < GT; r += 4 * S) {
        float hn[4][16];
        norm_rows<4>([&](int k) { const int rr = r + k * S; return p.out + (size_t)(tok0 + (rr < GT ? rr : r)) * 1024; }, gca,
                     [&](int k) { const int rr = r + k * S; return HQ + (size_t)(rr < GT ? rr : r) * 1024; },
                     [&](int k) { return r + k * S < GT; }, hn, lane);
      }
    }
    GSYNC();
    {
      EpiPlain e{QC, 1024};
      gemm_phase(HQ, 1024, WT_Q + (size_t)layer * 1024 * 1024, 1024, 1024, GT, 1024, smem, e);
    }
    GSYNC();
    {
      const int tid = opaque((int)threadIdx.x), lane = tid & 63, w = tid >> 6; (void)lane; (void)w;
      float* Ss = (float*)smem;
      u16* Ps = (u16*)(smem + 66560);
      const u16* KMl = KM + (size_t)layer * 2304 * 1024;
      const u16* VTl = VTM + (size_t)layer * 2304 * 1024;
      for (int t = bid; t < (GT / 64) * 4; t += nblk) {
        const int tile = t >> 2, h = t & 3;
        const int tk0 = tile * 64;
        const int sq_ = seq_of_tok(tok0 + tk0);
        const int tid_o = tid;
        const int wm = w >> 2, wn = w & 3;
        {
          f32x16 acc[1][2];
          zero_acc<1, 2>(acc);
          wave_mma_g<1, 2, true>(acc, QC + (size_t)(tk0 + wm * 32) * 1024 + h * 256, 1024, KMl + (size_t)(sq_ * 256 + wn * 64) * 1024 + h * 256, 1024, 256);
#pragma unroll
          for (int ni = 0; ni < 2; ++ni)
#pragma unroll
            for (int r = 0; r < 16; ++r) {
              const int rr = wm * 32 + (r & 3) + 8 * (r >> 2) + 4 * (lane >> 5);
              Ss[rr * 260 + wn * 64 + ni * 32 + (lane & 31)] = acc[0][ni][r] * 0.0625f;
            }
        }
        __syncthreads();
        {
          const int row = tid_o >> 3, sub = tid_o & 7;
          float mx = -1e30f;
#pragma unroll
          for (int j = 0; j < 32; ++j) mx = fmaxf(mx, Ss[row * 260 + sub * 32 + j]);
          mx = fmaxf(mx, __shfl_xor(mx, 1)); mx = fmaxf(mx, __shfl_xor(mx, 2)); mx = fmaxf(mx, __shfl_xor(mx, 4));
          float ev[32];
          float sm = 0.f;
#pragma unroll
          for (int j = 0; j < 32; ++j) { ev[j] = __expf(Ss[row * 260 + sub * 32 + j] - mx); sm += ev[j]; }
          sm += __shfl_xor(sm, 1); sm += __shfl_xor(sm, 2); sm += __shfl_xor(sm, 4);
          const float inv = 1.f / sm;
#pragma unroll
          for (int q = 0; q < 4; ++q) {
            uint4 u;
            u.x = pack2(ev[q * 8] * inv, ev[q * 8 + 1] * inv); u.y = pack2(ev[q * 8 + 2] * inv, ev[q * 8 + 3] * inv);
            u.z = pack2(ev[q * 8 + 4] * inv, ev[q * 8 + 5] * inv); u.w = pack2(ev[q * 8 + 6] * inv, ev[q * 8 + 7] * inv);
            *(uint4*)(Ps + row * 264 + sub * 32 + q * 8) = u;
          }
        }
        __syncthreads();
        {
          f32x16 acc[1][2];
          zero_acc<1, 2>(acc);
          wave_mma_g<1, 2, false>(acc, Ps + wm * 32 * 264, 264, VTl + ((size_t)sq_ * 1024 + h * 256 + wn * 64) * 256, 256, 256);
#pragma unroll
          for (int ni = 0; ni < 2; ++ni)
#pragma unroll
            for (int r = 0; r < 16; ++r) {
              const int rr = wm * 32 + (r & 3) + 8 * (r >> 2) + 4 * (lane >> 5);
              HQ[(size_t)(tk0 + rr) * 1024 + h * 256 + wn * 64 + ni * 32 + (lane & 31)] = f2bf(acc[0][ni][r]);
            }
        }
        __syncthreads();
      }
    }
    GSYNC();
    {
      EpiResid e{p, 1, tok0};
      gemm_phase(HQ, 1024, WT_O + (size_t)layer * 1024 * 1024, 1024, 1024, GT, 1024, smem, e);
    }
    GSYNC();
#endif
    }
  }
  {
    const int tid = opaque((int)threadIdx.x), lane = tid & 63, w = tid >> 6; (void)lane; (void)w;
    const float* gfin = p.in[7];
    const int S = nblk * 8;
    float4 gg[4];
#pragma unroll
    for (int i = 0; i < 4; ++i) gg[i] = *(const float4*)(gfin + i * 256 + lane * 4);
    for (int r = bid * 8 + w; r < TOK; r += 4 * S) {
      float4 v[4][4];
#pragma unroll
      for (int k = 0; k < 4; ++k) {
        const int rr = (r + k * S < TOK) ? r + k * S : r;
#pragma unroll
        for (int i = 0; i < 4; ++i) v[k][i] = *(const float4*)(p.out + (size_t)rr * 1024 + i * 256 + lane * 4);
      }
#pragma unroll
      for (int k = 0; k < 4; ++k) {
        float ss = 0.f;
#pragma unroll
        for (int i = 0; i < 4; ++i) ss += v[k][i].x * v[k][i].x + v[k][i].y * v[k][i].y + v[k][i].z * v[k][i].z + v[k][i].w * v[k][i].w;
        ss = wave_sum(ss);
        const float rr_ = rsqrtf(ss * (1.f / 1024.f) + 1e-6f);
        if (r + k * S < TOK) {
          float* x = p.out + (size_t)(r + k * S) * 1024;
#pragma unroll
          for (int i = 0; i < 4; ++i)
            *(float4*)(x + i * 256 + lane * 4) = make_float4(v[k][i].x * rr_ * gg[i].x, v[k][i].y * rr_ * gg[i].y, v[k][i].z * rr_ * gg[i].z, v[k][i].w * rr_ * gg[i].w);
        }
      }
    }
  }
}

extern "C" void kernel_launch(void* const* d_in, const int* in_sizes, int n_in, void* d_out, int out_size, void* d_ws,
                              size_t ws_size, hipStream_t stream) {
  static int grid_blocks = 0;
  if (!grid_blocks) {
    int dev = 0, cus = 0, per_cu = 0;
    hipGetDevice(&dev);
    hipDeviceGetAttribute(&cus, hipDeviceAttributeMultiprocessorCount, dev);
    hipOccupancyMaxActiveBlocksPerMultiprocessor(&per_cu, fwd_kernel, NTHR, 0);
    if (per_cu < 1) per_cu = 1;
    grid_blocks = cus * per_cu;
  }
  if (ws_size < WS_NEED) { fprintf(stderr, "workspace too small: %zu < %zu\n", ws_size, (size_t)WS_NEED); return; }
  Params p{};
  for (int i = 0; i < 32; ++i) p.in[i] = (const float*)d_in[i];
  p.out = (float*)d_out;
  p.ws = (char*)d_ws;
  hipMemsetAsync((char*)d_ws + OFF_BAR, 0, 16384, stream);
  void* args[] = {&p};
  hipError_t e = hipLaunchCooperativeKernel((void*)fwd_kernel, dim3(grid_blocks), dim3(NTHR), args, 0, stream);
  if (e != hipSuccess) fprintf(stderr, "cooperative launch failed: %s (grid %d)\n", hipGetErrorString(e), grid_blocks);
}
```
